# Optimizing an MI355X kernel written in HIP

```python
import math
import jax, jax.numpy as jnp
from jax import lax
import numpy as np

D_MODEL = 1024
BATCH = 16
SEQ = 2048
DEPTH = 4

HEAD_DIM = 64
NSA_HEADS = 6
NSA_KV_GROUPS = 2
NSA_REP = NSA_HEADS // NSA_KV_GROUPS
N_BRANCH = 3
CMP_LEN = 32
CMP_STRIDE = 16
CMP_HIDDEN = 2 * HEAD_DIM
SEL_BLOCK = 64
SEL_TOP_N = 16
WINDOW = 512
NSA_Q_BLOCK = 32
MLA_HEADS = 5
MLA_Q_RANK = 256
MLA_KV_RANK = 128
MLA_NOPE_DIM = 64
MLA_ROPE_DIM = 32
MLA_V_DIM = 64
ATTN_Q_BLOCK = 128
RET_HEADS = 5
RET_CHUNK = 128
ROPE_THETA = 500000.0
PARTIAL_ROPE_DIM = HEAD_DIM // 4
RET_THETA = 10000.0
D_FF = 4 * D_MODEL
NORM_EPS = 1e-6
NEG_INF = -1e30
FORCE_SCORE = 1e9

NSA_Q_W = NSA_HEADS * HEAD_DIM
NSA_KV_W = NSA_KV_GROUPS * HEAD_DIM
NSA_GATE_W = NSA_HEADS * N_BRANCH
MLA_OUT_W = MLA_HEADS * MLA_V_DIM
RET_W = RET_HEADS * HEAD_DIM
MIX_WIDTH = NSA_Q_W + MLA_OUT_W + RET_W
IN_SIZES = (NSA_Q_W, NSA_KV_W, NSA_KV_W, NSA_KV_W, NSA_KV_W, NSA_KV_W, NSA_KV_W, NSA_GATE_W,
            MLA_Q_RANK, MLA_KV_RANK, MLA_ROPE_DIM, RET_W, RET_W, RET_W, RET_W)
N_IN = sum(IN_SIZES)

kernel_name = 'hybrid_nsa_mla_retention'

F32 = jnp.float32


def in_offsets():
    return [int(o) for o in np.cumsum(IN_SIZES)[:-1]]


def rms_norm(x, gain):
    xf = x.astype(F32)
    y = xf * lax.rsqrt(jnp.mean(xf * xf, axis=-1, keepdims=True) + NORM_EPS) * gain.astype(F32)
    return y.astype(x.dtype)


def masked_softmax(s, mask):
    s = jnp.where(mask, s.astype(F32), NEG_INF)
    m = jnp.max(s, axis=-1, keepdims=True)
    p = jnp.exp(s - m) * mask
    return p / jnp.maximum(jnp.sum(p, axis=-1, keepdims=True), 1e-30)


def rope_tables(positions, dim, theta):
    inv = 1.0 / (theta ** (jnp.arange(0, dim, 2, dtype=F32) / dim))
    ang = positions.astype(F32)[..., None] * inv
    return jnp.cos(ang), jnp.sin(ang)


def apply_rope(x, cos, sin):
    half = x.shape[-1] // 2
    x1 = x[..., :half].astype(F32)
    x2 = x[..., half:].astype(F32)
    c = cos[:, :, None, :]
    s = sin[:, :, None, :]
    return jnp.concatenate([x1 * c - x2 * s, x2 * c + x1 * s], axis=-1).astype(x.dtype)


def partial_rope(x, cos, sin):
    return jnp.concatenate([apply_rope(x[..., :PARTIAL_ROPE_DIM], cos, sin), x[..., PARTIAL_ROPE_DIM:]], axis=-1)


def selection_overlap(n_cmp, n_sel):
    cs = np.arange(n_cmp) * CMP_STRIDE
    ce = cs + CMP_LEN
    ss = np.arange(n_sel) * SEL_BLOCK
    se = ss + SEL_BLOCK
    ov = np.clip(np.minimum(ce[:, None], se[None, :]) - np.maximum(cs[:, None], ss[None, :]), 0, None) / CMP_LEN
    return jnp.asarray(ov.astype(np.float32))


def compress_blocks(tok, tok_idx, pos_emb, w1, w2):
    b, _, g, dh = tok.shape
    blk = tok[:, tok_idx] + pos_emb[None, None, :, None, :]
    flat = blk.transpose(0, 1, 3, 2, 4).reshape(b, tok_idx.shape[0], g, CMP_LEN * dh)
    return jax.nn.gelu(flat @ w1) @ w2


def nsa_mixer(q, k_cmp, v_cmp, k_slc, v_slc, k_win, v_win, gates, pos_k, w1_k, w2_k, pos_v, w1_v, w2_v):
    b, s, _, dh = q.shape
    g, r = NSA_KV_GROUPS, NSA_REP
    n_cmp = (s - CMP_LEN) // CMP_STRIDE + 1
    n_sel = s // SEL_BLOCK
    top_n = min(SEL_TOP_N, n_sel)
    scale = dh ** -0.5
    qb_len = NSA_Q_BLOCK

    tok_idx = np.arange(n_cmp)[:, None] * CMP_STRIDE + np.arange(CMP_LEN)[None, :]
    kc = compress_blocks(k_cmp, tok_idx, pos_k, w1_k, w2_k)
    vc = compress_blocks(v_cmp, tok_idx, pos_v, w1_v, w2_v)
    cmp_end = jnp.arange(n_cmp) * CMP_STRIDE + CMP_LEN - 1
    overlap = selection_overlap(n_cmp, n_sel)

    ks_blk = k_slc.reshape(b, n_sel, SEL_BLOCK, g, dh).transpose(0, 3, 1, 2, 4)
    vs_blk = v_slc.reshape(b, n_sel, SEL_BLOCK, g, dh).transpose(0, 3, 1, 2, 4)
    kw_pad = jnp.pad(k_win, ((0, 0), (WINDOW, 0), (0, 0), (0, 0)))
    vw_pad = jnp.pad(v_win, ((0, 0), (WINDOW, 0), (0, 0), (0, 0)))

    n_qb = s // qb_len
    q_blocks = q.reshape(b, n_qb, qb_len, g, r, dh).transpose(1, 0, 2, 3, 4, 5)
    gate_blocks = jax.nn.sigmoid(gates.astype(F32)).reshape(b, n_qb, qb_len, g, r, N_BRANCH).transpose(1, 0, 2, 3, 4, 5)
    b_idx = jnp.arange(b)[:, None, None, None]
    g_idx = jnp.arange(g)[None, :, None, None]
    sel_ids = jnp.arange(n_sel)[None, :]

    def block(args):
        qb, gb, i = args
        q0 = i * qb_len
        t = q0 + jnp.arange(qb_len)
        s_c = jnp.einsum('bqgrd,bngd->bgrqn', qb, kc) * scale
        p_c = masked_softmax(s_c, cmp_end[None, :] <= t[:, None])
        o_c = jnp.einsum('bgrqn,bngd->bqgrd', p_c, vc)
        imp = jnp.einsum('bgrqn,nm->bgqm', p_c, overlap)
        cur = (t // SEL_BLOCK)[:, None]
        valid = sel_ids <= cur
        forced = (sel_ids == 0) | (sel_ids == cur) | (sel_ids == cur - 1)
        imp = jnp.where(valid & forced, FORCE_SCORE, imp)
        imp = jnp.where(valid, imp, NEG_INF)
        _, idx = lax.top_k(imp, top_n)
        k_sel = ks_blk[b_idx, g_idx, idx]
        v_sel = vs_blk[b_idx, g_idx, idx]
        key_pos = idx[..., None] * SEL_BLOCK + jnp.arange(SEL_BLOCK)
        mask_s = (key_pos <= t[None, None, :, None, None]).reshape(b, g, 1, qb_len, top_n * SEL_BLOCK)
        s_s = jnp.einsum('bqgrd,bgqjsd->bgrqjs', qb, k_sel).reshape(b, g, r, qb_len, top_n * SEL_BLOCK) * scale
        p_s = masked_softmax(s_s, mask_s).reshape(b, g, r, qb_len, top_n, SEL_BLOCK)
        o_s = jnp.einsum('bgrqjs,bgqjsd->bqgrd', p_s, v_sel)
        kw = lax.dynamic_slice_in_dim(kw_pad, q0, qb_len + WINDOW, axis=1)
        vw = lax.dynamic_slice_in_dim(vw_pad, q0, qb_len + WINDOW, axis=1)
        kp = (q0 - WINDOW + jnp.arange(qb_len + WINDOW))[None, :]
        mask_w = (kp <= t[:, None]) & (kp > t[:, None] - WINDOW) & (kp >= 0)
        s_w = jnp.einsum('bqgrd,bkgd->bgrqk', qb, kw) * scale
        p_w = masked_softmax(s_w, mask_w)
        o_w = jnp.einsum('bgrqk,bkgd->bqgrd', p_w, vw)
        return gb[..., 0:1] * o_c + gb[..., 1:2] * o_s + gb[..., 2:3] * o_w

    out = lax.map(block, (q_blocks, gate_blocks, jnp.arange(n_qb)))
    return out.transpose(1, 0, 2, 3, 4, 5).reshape(b, s, NSA_HEADS * dh)


def causal_block_attention(q, k, v, scale):
    b, s, h, dq = q.shape
    n_qb = s // ATTN_Q_BLOCK
    q_blocks = q.reshape(b, n_qb, ATTN_Q_BLOCK, h, dq).transpose(1, 0, 2, 3, 4)
    kp = jnp.arange(s)[None, :]

    def block(args):
        qi, i = args
        t = (i * ATTN_Q_BLOCK + jnp.arange(ATTN_Q_BLOCK))[:, None]
        sc = jnp.einsum('bqhd,bkhd->bhqk', qi, k) * scale
        p = masked_softmax(sc, kp <= t)
        return jnp.einsum('bhqk,bkhd->bqhd', p, v)

    out = lax.map(block, (q_blocks, jnp.arange(n_qb)))
    return out.transpose(1, 0, 2, 3, 4).reshape(b, s, h, v.shape[-1])


def mla_mixer(c_q, c_kv, k_pe, q_norm, w_uq, kv_norm, w_ukv, cos, sin):
    b, s, _ = c_q.shape
    q = (rms_norm(c_q, q_norm) @ w_uq).reshape(b, s, MLA_HEADS, MLA_NOPE_DIM + MLA_ROPE_DIM)
    q_nope, q_pe = q[..., :MLA_NOPE_DIM], apply_rope(q[..., MLA_NOPE_DIM:], cos, sin)
    kv = (rms_norm(c_kv, kv_norm) @ w_ukv).reshape(b, s, MLA_HEADS, MLA_NOPE_DIM + MLA_V_DIM)
    k_nope, v = kv[..., :MLA_NOPE_DIM], kv[..., MLA_NOPE_DIM:]
    k_pe = apply_rope(k_pe[:, :, None, :], cos, sin)
    q_full = jnp.concatenate([q_nope, q_pe], axis=-1)
    k_full = jnp.concatenate([k_nope, jnp.broadcast_to(k_pe, (b, s, MLA_HEADS, MLA_ROPE_DIM)).astype(k_nope.dtype)], axis=-1)
    o = causal_block_attention(q_full, k_full, v, (MLA_NOPE_DIM + MLA_ROPE_DIM) ** -0.5)
    return o.reshape(b, s, MLA_OUT_W)


def chunkwise_retention(q, k, v):
    b, s, h, d = q.shape
    n = s // RET_CHUNK
    log_g = jnp.log(1.0 - 2.0 ** (-5.0 - jnp.arange(h, dtype=F32)))
    i = jnp.arange(RET_CHUNK, dtype=F32)
    diff = i[:, None] - i[None, :]
    intra = jnp.where(diff >= 0, jnp.exp(jnp.maximum(diff, 0.0)[None] * log_g[:, None, None]), 0.0)
    read_decay = jnp.exp((i + 1.0)[None, :] * log_g[:, None])[None, :, :, None]
    write_decay = jnp.exp((RET_CHUNK - 1.0 - i)[None, :] * log_g[:, None])[None, :, :, None]
    chunk_decay = jnp.exp(RET_CHUNK * log_g)[None, :, None, None]

    def to_chunks(a):
        return a.reshape(b, n, RET_CHUNK, h, d).transpose(1, 0, 3, 2, 4)

    def step(state, xs):
        qc, kc, vc = xs
        sc = jnp.einsum('bhid,bhjd->bhij', qc, kc) * intra
        o = jnp.einsum('bhij,bhjd->bhid', sc, vc) + jnp.einsum('bhid,bhde->bhie', qc, state) * read_decay
        state = state * chunk_decay + jnp.einsum('bhjd,bhje->bhde', kc * write_decay, vc)
        return state, o

    state0 = jnp.zeros((b, h, d, d), F32)
    _, outs = lax.scan(step, state0, (to_chunks(q), to_chunks(k), to_chunks(v)))
    return outs.transpose(1, 0, 3, 2, 4).reshape(b, s, h, d)


def retention_mixer(q, k, v, gate, gn_gain, cos, sin):
    b, s, _ = q.shape
    h, d = RET_HEADS, HEAD_DIM
    q = apply_rope(q.reshape(b, s, h, d), cos, sin).astype(F32)
    k = apply_rope(k.reshape(b, s, h, d), cos, sin).astype(F32) * (d ** -0.5)
    v = v.reshape(b, s, h, d).astype(F32)
    o = chunkwise_retention(q, k, v)
    mu = jnp.mean(o, axis=-1, keepdims=True)
    var = jnp.mean(jnp.square(o - mu), axis=-1, keepdims=True)
    o = (o - mu) * lax.rsqrt(var + NORM_EPS) * gn_gain.astype(F32)
    return jax.nn.silu(gate.astype(F32)) * o.reshape(b, s, h * d)


def setup_inputs(seed: int = 0) -> dict:
    key = jax.random.key(seed)
    ks = jax.random.split(key, 24)

    def nrm(k, shape, scale):
        return scale * jax.random.normal(k, shape, F32)

    def gain(k, shape):
        return 1.0 + 0.02 * jax.random.normal(k, shape, F32)

    offs = jax.random.randint(ks[1], (BATCH, 1), 0, 4096)
    positions = (jnp.arange(SEQ, dtype=jnp.int32)[None, :] + offs).astype(jnp.int32)
    return {
        'x': nrm(ks[0], (BATCH, SEQ, D_MODEL), 1.0),
        'positions': positions,
        'ln1_gain': gain(ks[2], (DEPTH, D_MODEL)),
        'w_in': nrm(ks[3], (DEPTH, D_MODEL, N_IN), D_MODEL ** -0.5),
        'cmp_pos_k': nrm(ks[4], (DEPTH, CMP_LEN, HEAD_DIM), 0.1),
        'cmp_w1_k': nrm(ks[5], (DEPTH, CMP_LEN * HEAD_DIM, CMP_HIDDEN), (CMP_LEN * HEAD_DIM) ** -0.5),
        'cmp_w2_k': nrm(ks[6], (DEPTH, CMP_HIDDEN, HEAD_DIM), CMP_HIDDEN ** -0.5),
        'cmp_pos_v': nrm(ks[7], (DEPTH, CMP_LEN, HEAD_DIM), 0.1),
        'cmp_w1_v': nrm(ks[8], (DEPTH, CMP_LEN * HEAD_DIM, CMP_HIDDEN), (CMP_LEN * HEAD_DIM) ** -0.5),
        'cmp_w2_v': nrm(ks[9], (DEPTH, CMP_HIDDEN, HEAD_DIM), CMP_HIDDEN ** -0.5),
        'mla_q_norm': gain(ks[10], (DEPTH, MLA_Q_RANK)),
        'mla_w_uq': nrm(ks[11], (DEPTH, MLA_Q_RANK, MLA_HEADS * (MLA_NOPE_DIM + MLA_ROPE_DIM)), MLA_Q_RANK ** -0.5),
        'mla_kv_norm': gain(ks[12], (DEPTH, MLA_KV_RANK)),
        'mla_w_ukv': nrm(ks[13], (DEPTH, MLA_KV_RANK, MLA_HEADS * (MLA_NOPE_DIM + MLA_V_DIM)), MLA_KV_RANK ** -0.5),
        'ret_gn_gain': gain(ks[14], (DEPTH, RET_HEADS, HEAD_DIM)),
        'w_out': nrm(ks[15], (DEPTH, MIX_WIDTH, D_MODEL), MIX_WIDTH ** -0.5),
        'ln2_gain': gain(ks[16], (DEPTH, D_MODEL)),
        'w_up': nrm(ks[17], (DEPTH, D_MODEL, D_FF), D_MODEL ** -0.5),
        'w_down': nrm(ks[18], (DEPTH, D_FF, D_MODEL), D_FF ** -0.5),
        'final_gain': gain(ks[19], (D_MODEL,)),
    }


def reference(x, positions, ln1_gain, w_in, cmp_pos_k, cmp_w1_k, cmp_w2_k, cmp_pos_v, cmp_w1_v, cmp_w2_v,
              mla_q_norm, mla_w_uq, mla_kv_norm, mla_w_ukv, ret_gn_gain, w_out, ln2_gain, w_up, w_down,
              final_gain):
    b, s, _ = x.shape
    cos_p, sin_p = rope_tables(positions, PARTIAL_ROPE_DIM, ROPE_THETA)
    cos_m, sin_m = rope_tables(positions, MLA_ROPE_DIM, ROPE_THETA)
    cos_r, sin_r = rope_tables(positions, HEAD_DIM, RET_THETA)
    offsets = in_offsets()
    for l in range(DEPTH):
        h = rms_norm(x, ln1_gain[l])
        proj = h @ w_in[l]
        (nsa_q, k_cmp, v_cmp, k_slc, v_slc, k_win, v_win, nsa_gate,
         mla_cq, mla_ckv, mla_kpe, ret_q, ret_k, ret_v, ret_gate) = jnp.split(proj, offsets, axis=-1)

        def kv_heads(a):
            return a.reshape(b, s, NSA_KV_GROUPS, HEAD_DIM)

        o_nsa = nsa_mixer(
            partial_rope(nsa_q.reshape(b, s, NSA_HEADS, HEAD_DIM), cos_p, sin_p),
            partial_rope(kv_heads(k_cmp), cos_p, sin_p), kv_heads(v_cmp),
            partial_rope(kv_heads(k_slc), cos_p, sin_p), kv_heads(v_slc),
            partial_rope(kv_heads(k_win), cos_p, sin_p), kv_heads(v_win),
            nsa_gate.reshape(b, s, NSA_HEADS, N_BRANCH),
            cmp_pos_k[l], cmp_w1_k[l], cmp_w2_k[l], cmp_pos_v[l], cmp_w1_v[l], cmp_w2_v[l])
        o_mla = mla_mixer(mla_cq, mla_ckv, mla_kpe, mla_q_norm[l], mla_w_uq[l], mla_kv_norm[l], mla_w_ukv[l],
                          cos_m, sin_m)
        o_ret = retention_mixer(ret_q, ret_k, ret_v, ret_gate, ret_gn_gain[l], cos_r, sin_r)
        mixed = jnp.concatenate([o_nsa.astype(x.dtype), o_mla.astype(x.dtype), o_ret.astype(x.dtype)], axis=-1)
        x = x + mixed @ w_out[l]
        h = rms_norm(x, ln2_gain[l])
        x = x + jnp.square(jax.nn.relu(h @ w_up[l])) @ w_down[l]
    return rms_norm(x, final_gain)
```

```cpp
#include <hip/hip_runtime.h>
#include <hip/hip_cooperative_groups.h>
#include <cstdio>
#include <cstdint>
namespace cg = cooperative_groups;

typedef unsigned short bf16_t;
typedef short bf16x8 __attribute__((ext_vector_type(8)));
typedef float f32x4 __attribute__((ext_vector_type(4)));
typedef unsigned u32x4 __attribute__((ext_vector_type(4)));
typedef unsigned u32x2 __attribute__((ext_vector_type(2)));
#define DEVI __device__ __forceinline__

constexpr int T = 32768, S = 2048, DM = 1024, DFF = 4096;
constexpr int PS = 2304;
constexpr int NIN = 3072;
constexpr int C_Q = 0, C_KCMP = 384, C_VCMP = 512, C_KSLC = 640, C_KWIN = 768, C_GATE = 896, C_CQ = 928, C_CKV = 1184,
              C_KPE = 1312, C_RQ = 1344, C_RK = 1664, C_RG = 1984, C_VSLC = 2304, C_VWIN = 2432, C_RV = 2560, C_END = 2880;
constexpr float LOG2E = 1.4426950408889634f;
constexpr float QSCALE_NSA = 0.125f * LOG2E;
constexpr float QSCALE_MLA = 0.10206207261596575f * LOG2E;

constexpr size_t MiB = 1ull << 20;
constexpr size_t WS_U = 0, WS_PROJ = 0, WS_MIXED = 144 * MiB, WS_QM = 208 * MiB, WS_VSLCT = 240 * MiB, WS_VWINT = 248 * MiB;
constexpr size_t WS_XB = 256 * MiB, WS_KN = 320 * MiB, WS_RETVT = 340 * MiB, WS_MLAVT = 360 * MiB, WS_HID = 380 * MiB;
constexpr size_t WS_KC = 382 * MiB, WS_VCT = WS_KC + 512 * 1024, WS_ROPE = 383 * MiB;
constexpr size_t WS_WIN = 397 * MiB, WS_WOUT = 421 * MiB, WS_WUP = 429 * MiB, WS_WDOWN = 461 * MiB, WS_W1 = 493 * MiB;
constexpr size_t WS_W2 = 497 * MiB, WS_WUQ = 498 * MiB, WS_WUKV = 499 * MiB, WS_C1 = 500 * MiB, WS_CTR = WS_C1 + 65536, WS_SS = 502 * MiB;

constexpr int LDS_ROW = 144;
constexpr int LDS_A_BYTES = 256 * LDS_ROW, LDS_B_BYTES = 128 * LDS_ROW, LDS_STAGE = LDS_A_BYTES + LDS_B_BYTES;
constexpr int LDS_RS_OFF = 2 * LDS_STAGE;
constexpr int LDS_SLOT = 131072;
constexpr int LDS_TOTAL = LDS_SLOT + 64;
constexpr int KROW_MLA = 208;
constexpr int ATT_K0 = 0, ATT_KSZ = 64 * KROW_MLA, ATT_V0 = 2 * ATT_KSZ, ATT_VSZ = 64 * LDS_ROW;
constexpr int ATT_IMPA = ATT_V0 + 2 * ATT_VSZ, ATT_IMPB = ATT_IMPA + 128 * 33 * 4, ATT_SELM = ATT_IMPB + 128 * 33 * 4, ATT_BMASK = ATT_SELM + 512;
constexpr int RET_KS = 0, RET_KWT = 128 * LDS_ROW, RET_ROWT = 272, RET_VT = RET_KWT + 64 * RET_ROWT, RET_ST = RET_VT + 64 * RET_ROWT;

struct Params { const float* in[20]; float* out; unsigned char* ws; };

DEVI float bf2f(bf16_t b) { return __uint_as_float(((unsigned)b) << 16); }
DEVI unsigned pk2(float lo, float hi) { unsigned r; asm("v_cvt_pk_bf16_f32 %0, %1, %2" : "=v"(r) : "v"(lo), "v"(hi)); return r; }
DEVI bf16_t f2bf(float f) { return (bf16_t)(pk2(f, 0.f) & 0xffffu); }
DEVI f32x4 mfma16(bf16x8 a, bf16x8 b, f32x4 c) { return __builtin_amdgcn_mfma_f32_16x16x32_bf16(a, b, c, 0, 0, 0); }
DEVI float fexp2(float x) { return __builtin_amdgcn_exp2f(x); }
DEVI bf16x8 as_bf8(u32x4 u) { union { u32x4 u; bf16x8 b; } x; x.u = u; return x.b; }
DEVI void store_bf4(bf16_t* p, f32x4 v) { u32x2 w; w.x = pk2(v[0], v[1]); w.y = pk2(v[2], v[3]); *(u32x2*)p = w; }
DEVI float sigmoidf(float x) { return 1.f / (1.f + __expf(-x)); }

DEVI int opaque_tid(int wv) { int t; asm volatile("v_mbcnt_lo_u32_b32 %0, -1, 0\n\tv_mbcnt_hi_u32_b32 %0, -1, %0" : "=v"(t)); return wv * 64 + t; }
template <int M> DEVI float shx(float v) { return __int_as_float(__builtin_amdgcn_ds_swizzle(__float_as_int(v), (M << 10) | 0x1f)); }
template <int M> DEVI unsigned shxu(unsigned v) { return (unsigned)__builtin_amdgcn_ds_swizzle((int)v, (M << 10) | 0x1f); }
DEVI float shx32(float v, int lane) { return __int_as_float(__builtin_amdgcn_ds_bpermute((lane ^ 32) << 2, __float_as_int(v))); }
DEVI int permd(int d, int half) { return (d < 2 * half) ? ((d & 1) ? (d >> 1) + half : (d >> 1)) : d; }
DEVI int inproj_src_col(int n) {
  if (n < 384) return (n & ~63) + permd(n & 63, 8);
  if (n < 512) { int e = n - 384; return 384 + (e & ~63) + permd(e & 63, 8); }
  if (n < 640) return n;
  if (n < 768) { int e = n - 640; return 640 + (e & ~63) + permd(e & 63, 8); }
  if (n < 896) { int e = n - 768; return 896 + (e & ~63) + permd(e & 63, 8); }
  if (n < 928) { int e = n - 896; return e < 18 ? 1152 + e : -1; }
  if (n < 1184) return 1170 + (n - 928);
  if (n < 1312) return 1426 + (n - 1184);
  if (n < 1344) return 1554 + permd(n - 1312, 16);
  if (n < 1664) { int e = n - 1344; return 1586 + (e & ~63) + permd(e & 63, 32); }
  if (n < 1984) { int e = n - 1664; return 1906 + (e & ~63) + permd(e & 63, 32); }
  if (n < 2304) return 2546 + (n - 1984);
  if (n < 2432) return 768 + (n - 2304);
  if (n < 2560) return 1024 + (n - 2432);
  if (n < 2880) return 2226 + (n - 2560);
  return -1;
}
DEVI int map_col(int kind, int n) {
  switch (kind) {
    case 0: return inproj_src_col(n);
    case 6: return n < 64 ? permd(n, 8) : -1;
    case 7: return n < 64 ? n : -1;
    case 8: { if (n >= 480) return -1; int h = n / 96, d = n % 96; return h * 96 + (d < 64 ? d : 64 + permd(d - 64, 16)); }
    case 9: { if (n < 320) { return (n >> 6) * 128 + (n & 63); } int e = n - 320; return (e >> 6) * 128 + 64 + (e & 63); }
    default: return n;
  }
}
DEVI int map_row(int kind, int k) { return kind == 4 ? (k & ~63) + permd(k & 63, 8) : k; }

DEVI void transpose_tile(const float* __restrict__ src, int ldsrc, bf16_t* __restrict__ dst, int K, int k0, int n0,
                         const float* __restrict__ gain, int kind, float* lt, int wv) {
  const int tid = opaque_tid(wv);
  const int nn = tid & 127, kq = tid >> 7;
  const int sc = map_col(kind, n0 + nn);
  float v[16];
#pragma unroll
  for (int i = 0; i < 16; ++i) {
    const int kk = kq + i * 4;
    v[i] = 0.f;
    if (sc >= 0) { const int sr = map_row(kind, k0 + kk); v[i] = src[(size_t)sr * ldsrc + sc]; if (gain) v[i] *= gain[k0 + kk]; }
  }
#pragma unroll
  for (int i = 0; i < 16; ++i) lt[nn * 65 + kq + i * 4] = v[i];
  __syncthreads();
#pragma unroll
  for (int h = 0; h < 2; ++h) {
    const int kc = tid & 7, n2 = (tid >> 3) + h * 64;
    const float* p = lt + n2 * 65 + kc * 8;
    u32x4 w; w.x = pk2(p[0], p[1]); w.y = pk2(p[2], p[3]); w.z = pk2(p[4], p[5]); w.w = pk2(p[6], p[7]);
    *(u32x4*)(dst + (size_t)(n0 + n2) * K + k0 + kc * 8) = w;
  }
  __syncthreads();
}

struct ADLin { const bf16_t* base; int lda; int kstride; DEVI const bf16_t* rowptr(int m) const { return base + (size_t)m * lda; } };
struct ADCmp { const bf16_t* base; int kstride;
  DEVI const bf16_t* rowptr(int m) const { int b = m >> 8, n = (m >> 1) & 127, g = m & 1; if (n > 126) n = 126; return base + ((size_t)(b * S + n * 16)) * PS + g * 64; } };

template <bool ROWSS, class AD, class Epi>
DEVI void gemm_tile(const AD& ad, const bf16_t* __restrict__ Bt, int K, int m0, int n0, const Epi& epi, unsigned char* lds, int wv) {
  const int tid = opaque_tid(wv), lane = tid & 63, wave = tid >> 6;
  const int idx = lane & 15, quad = lane >> 4;
  const int wm = wave >> 1, wn = wave & 1;
  const int lc = tid & 7, lr = tid >> 3;
  const bf16_t* ap[4]; const bf16_t* bp[2];
#pragma unroll
  for (int i = 0; i < 4; ++i) ap[i] = ad.rowptr(m0 + lr + 64 * i) + lc * 8;
#pragma unroll
  for (int i = 0; i < 2; ++i) bp[i] = Bt + (size_t)(n0 + lr + 64 * i) * K + lc * 8;
  const int aks = ad.kstride;
  u32x4 ra[4], rb[2];
  float ss[4] = {0.f, 0.f, 0.f, 0.f};
  f32x4 acc[4][4];
#pragma unroll
  for (int i = 0; i < 4; ++i)
#pragma unroll
    for (int j = 0; j < 4; ++j) acc[i][j] = (f32x4){0.f, 0.f, 0.f, 0.f};
  const int nk = K >> 6;
#pragma unroll
  for (int i = 0; i < 4; ++i) ra[i] = *(const u32x4*)(ap[i]);
#pragma unroll
  for (int i = 0; i < 2; ++i) rb[i] = *(const u32x4*)(bp[i]);
  auto stage_write = [&](int s) {
    unsigned char* A = lds + s * LDS_STAGE; unsigned char* B = A + LDS_A_BYTES;
#pragma unroll
    for (int i = 0; i < 4; ++i) *(u32x4*)(A + (lr + 64 * i) * LDS_ROW + lc * 16) = ra[i];
#pragma unroll
    for (int i = 0; i < 2; ++i) *(u32x4*)(B + (lr + 64 * i) * LDS_ROW + lc * 16) = rb[i];
    if (ROWSS) {
#pragma unroll
      for (int i = 0; i < 4; ++i)
#pragma unroll
        for (int e = 0; e < 4; ++e) { unsigned w = ra[i][e]; float lo = __uint_as_float(w << 16), hi = __uint_as_float(w & 0xffff0000u); ss[i] += lo * lo + hi * hi; }
    }
  };
  stage_write(0);
  __syncthreads();
#pragma unroll 1
  for (int kk = 0; kk < nk; ++kk) {
    if (kk + 1 < nk) {
#pragma unroll
      for (int i = 0; i < 4; ++i) ra[i] = *(const u32x4*)(ap[i] + (size_t)(kk + 1) * aks);
#pragma unroll
      for (int i = 0; i < 2; ++i) rb[i] = *(const u32x4*)(bp[i] + (kk + 1) * 64);
    }
    const unsigned char* A = lds + (kk & 1) * LDS_STAGE + (wm * 64 + idx) * LDS_ROW + quad * 16;
    const unsigned char* B = lds + (kk & 1) * LDS_STAGE + LDS_A_BYTES + (wn * 64 + idx) * LDS_ROW + quad * 16;
#pragma unroll
    for (int ks = 0; ks < 2; ++ks) {
      bf16x8 af[4], wf[4];
#pragma unroll
      for (int i = 0; i < 4; ++i) af[i] = *(const bf16x8*)(A + i * 16 * LDS_ROW + ks * 64);
#pragma unroll
      for (int j = 0; j < 4; ++j) wf[j] = *(const bf16x8*)(B + j * 16 * LDS_ROW + ks * 64);
#pragma unroll
      for (int i = 0; i < 4; ++i)
#pragma unroll
        for (int j = 0; j < 4; ++j) acc[i][j] = mfma16(wf[j], af[i], acc[i][j]);
    }
    if (kk + 1 < nk) stage_write((kk + 1) & 1);
    __syncthreads();
  }
  float rs[4] = {1.f, 1.f, 1.f, 1.f};
  if (ROWSS) {
    float* rsl = (float*)(lds + LDS_RS_OFF);
#pragma unroll
    for (int i = 0; i < 4; ++i) {
      float v = ss[i]; v += shx<1>(v); v += shx<2>(v); v += shx<4>(v);
      if (lc == 0) rsl[lr + 64 * i] = rsqrtf(v / (float)K + 1e-6f);
    }
    __syncthreads();
#pragma unroll
    for (int i = 0; i < 4; ++i) rs[i] = rsl[wm * 64 + i * 16 + idx];
  }
#pragma unroll
  for (int j = 0; j < 4; ++j) {
    const int n = n0 + wn * 64 + j * 16 + quad * 4;
#pragma unroll
    for (int i = 0; i < 4; ++i) epi(m0 + wm * 64 + i * 16 + idx, n, acc[i][j], rs[i]);
  }
}

struct EpiInProj {
  bf16_t* proj; bf16_t* vslcT; bf16_t* vwinT; bf16_t* retvT; const float* rope;
  DEVI void operator()(int m, int n, f32x4 v, float rs) const {
    if (n >= C_END) return;
    v *= rs;
    if (n < C_VSLC) {
      int ri = -1; float sc = 1.f;
      if (n < C_VCMP) { int d = n & 63; if (d < 16) ri = d >> 1; if (n < C_KCMP) sc = QSCALE_NSA; }
      else if (n < C_KSLC) {}
      else if (n < C_GATE) { int d = n & 63; if (d < 16) ri = d >> 1; }
      else if (n < C_KPE) {}
      else if (n < C_RQ) { ri = 8 + ((n - C_KPE) >> 1); }
      else if (n < C_RG) { int d = (n - C_RQ) & 63; ri = 24 + (d >> 1); if (n >= C_RK) sc = 0.125f; }
      if (ri >= 0) {
        const float4 cs = *(const float4*)(rope + ((size_t)m * 56 + ri) * 2);
        float a0 = v[0] * cs.x - v[1] * cs.y, a1 = v[1] * cs.x + v[0] * cs.y;
        float a2 = v[2] * cs.z - v[3] * cs.w, a3 = v[3] * cs.z + v[2] * cs.w;
        v = (f32x4){a0, a1, a2, a3};
      }
      v *= sc;
      store_bf4(proj + (size_t)m * PS + n, v);
    } else {
      const int b = m >> 11, s = m & 2047;
      bf16_t* dst;
      if (n < C_VWIN) { int e = n - C_VSLC; dst = vslcT + ((size_t)((b * 2 + (e >> 6)) * 64 + (e & 63))) * S + s; }
      else if (n < C_RV) { int e = n - C_VWIN; dst = vwinT + ((size_t)((b * 2 + (e >> 6)) * 64 + (e & 63))) * S + s; }
      else { int e = n - C_RV; dst = retvT + ((size_t)((b * 5 + (e >> 6)) * 64 + (e & 63))) * S + s; }
#pragma unroll
      for (int j = 0; j < 4; ++j) dst[(size_t)j * S] = f2bf(v[j]);
    }
  }
};
struct EpiMlaQ {
  bf16_t* qm; const float* rope;
  DEVI void operator()(int m, int n, f32x4 v, float rs) const {
    if (n >= 480) return;
    v *= rs;
    int d = n % 96;
    if (d >= 64) {
      const float4 cs = *(const float4*)(rope + ((size_t)m * 56 + 8 + ((d - 64) >> 1)) * 2);
      float a0 = v[0] * cs.x - v[1] * cs.y, a1 = v[1] * cs.x + v[0] * cs.y;
      float a2 = v[2] * cs.z - v[3] * cs.w, a3 = v[3] * cs.z + v[2] * cs.w;
      v = (f32x4){a0, a1, a2, a3};
    }
    v *= QSCALE_MLA;
    store_bf4(qm + (size_t)m * 512 + n, v);
  }
};
struct EpiMlaKV {
  bf16_t* kn; bf16_t* mlavT;
  DEVI void operator()(int m, int n, f32x4 v, float rs) const {
    v *= rs;
    if (n < 320) { store_bf4(kn + (size_t)m * 320 + n, v); }
    else {
      const int b = m >> 11, s = m & 2047; int e = n - 320;
      bf16_t* dst = mlavT + ((size_t)((b * 5 + (e >> 6)) * 64 + (e & 63))) * S + s;
#pragma unroll
      for (int j = 0; j < 4; ++j) dst[(size_t)j * S] = f2bf(v[j]);
    }
  }
};
struct EpiCmp1 {
  bf16_t* hid; const float* c1;
  DEVI void operator()(int m, int n, f32x4 v, float) const {
    const float4 bb = *(const float4*)(c1 + n);
    float x[4] = {v[0] + bb.x, v[1] + bb.y, v[2] + bb.z, v[3] + bb.w};
    f32x4 o;
#pragma unroll
    for (int j = 0; j < 4; ++j) {
      float y = 0.7978845608028654f * (x[j] + 0.044715f * x[j] * x[j] * x[j]);
      float th = 1.f - 2.f / (__expf(2.f * y) + 1.f);
      o[j] = 0.5f * x[j] * (1.f + th);
    }
    store_bf4(hid + (size_t)m * 128 + n, o);
  }
};
struct EpiCmp2 {
  bf16_t* kc; bf16_t* vcT; int kv;
  DEVI void operator()(int m, int n, f32x4 v, float) const {
    if (n >= 64) return;
    if (kv == 0) { store_bf4(kc + (size_t)m * 64 + n, v); }
    else {
      int b = m >> 8, nc = (m >> 1) & 127, g = m & 1;
      bf16_t* dst = vcT + ((size_t)((b * 2 + g) * 64 + n)) * 128 + nc;
#pragma unroll
      for (int j = 0; j < 4; ++j) dst[j * 128] = f2bf(v[j]);
    }
  }
};
struct EpiResid {
  float* xf; bf16_t* xb;
  DEVI void operator()(int m, int n, f32x4 v, float) const {
    float* p = xf + (size_t)m * DM + n;
    f32x4 x = *(const f32x4*)p;
    x += v;
    *(f32x4*)p = x;
    store_bf4(xb + (size_t)m * DM + n, x);
  }
};
struct EpiRelu2 {
  bf16_t* u;
  DEVI void operator()(int m, int n, f32x4 v, float rs) const {
    f32x4 o;
#pragma unroll
    for (int j = 0; j < 4; ++j) { float h = fmaxf(v[j] * rs, 0.f); o[j] = h * h; }
    store_bf4(u + (size_t)m * DFF + n, o);
  }
};

#define SCHED_BARRIER() __builtin_amdgcn_sched_barrier(0)
template <int NC, int KS>
DEVI void qk_half(const unsigned char* Kl, int krow, const bf16x8 (&q)[NC][KS], f32x4 (&s)[NC][2], int idx, int quad) {
#pragma unroll
  for (int u = 0; u < 2; ++u) {
#pragma unroll
    for (int c = 0; c < NC; ++c) s[c][u] = (f32x4){0.f, 0.f, 0.f, 0.f};
#pragma unroll
    for (int ks = 0; ks < KS; ++ks) {
      bf16x8 kf = *(const bf16x8*)(Kl + (u * 16 + idx) * krow + ks * 64 + quad * 16);
#pragma unroll
      for (int c = 0; c < NC; ++c) s[c][u] = mfma16(kf, q[c][ks], s[c][u]);
    }
  }
}
template <int NC>
DEVI void pv_half(const unsigned char* Vl, int vrow, const bf16x8 (&pb)[NC], f32x4 (&o)[NC][4], int idx, int quad) {
#pragma unroll
  for (int dvt = 0; dvt < 4; ++dvt) {
    const unsigned char* p = Vl + (dvt * 16 + idx) * vrow + quad * 8;
    u32x2 lo = *(const u32x2*)p, hi = *(const u32x2*)(p + 32);
    bf16x8 vf = as_bf8((u32x4){lo.x, lo.y, hi.x, hi.y});
#pragma unroll
    for (int c = 0; c < NC; ++c) o[c][dvt] = mfma16(vf, pb[c], o[c][dvt]);
  }
}
DEVI bf16x8 pack_p(const f32x4& a, const f32x4& b) { return as_bf8((u32x4){pk2(a[0], a[1]), pk2(a[2], a[3]), pk2(b[0], b[1]), pk2(b[2], b[3])}); }
template <int NC, int KS, class MaskF>
DEVI void attn_tile(const unsigned char* Kl, int krow, const unsigned char* Vl, const bf16x8 (&q)[NC][KS], f32x4 (&o)[NC][4],
                    float (&mr)[NC], float (&lr)[NC], int idx, int quad, bool need_mask, const MaskF& mf) {
#pragma unroll
  for (int hf = 0; hf < 2; ++hf) {
    f32x4 s[NC][2];
    qk_half<NC, KS>(Kl + hf * 32 * krow, krow, q, s, idx, quad);
    bf16x8 pb[NC];
#pragma unroll
    for (int c = 0; c < NC; ++c) {
      if (need_mask) {
#pragma unroll
        for (int u = 0; u < 2; ++u)
#pragma unroll
          for (int j = 0; j < 4; ++j) s[c][u][j] = mf(c, hf * 32 + u * 16 + quad * 4 + j) ? s[c][u][j] : -1e30f;
      }
      float ps = 0.f;
      f32x4 p0, p1;
#pragma unroll
      for (int j = 0; j < 4; ++j) { p0[j] = fexp2(s[c][0][j] - mr[c]); p1[j] = fexp2(s[c][1][j] - mr[c]); ps += p0[j] + p1[j]; }
      if (__builtin_amdgcn_ballot_w64(!(ps <= 2048.f)) != 0ull) {
        float mx = fmaxf(fmaxf(fmaxf(s[c][0][0], s[c][0][1]), fmaxf(s[c][0][2], s[c][0][3])), fmaxf(fmaxf(s[c][1][0], s[c][1][1]), fmaxf(s[c][1][2], s[c][1][3])));
        mx = fmaxf(mx, shx<16>(mx)); mx = fmaxf(mx, shx32(mx, quad * 16 + idx));
        const float mnew = fmaxf(mr[c], mx);
        const float alpha = fexp2(mr[c] - mnew);
        lr[c] *= alpha; mr[c] = mnew;
#pragma unroll
        for (int dvt = 0; dvt < 4; ++dvt) o[c][dvt] *= alpha;
        ps = 0.f;
#pragma unroll
        for (int j = 0; j < 4; ++j) { p0[j] = fexp2(s[c][0][j] - mnew); p1[j] = fexp2(s[c][1][j] - mnew); ps += p0[j] + p1[j]; }
      }
      lr[c] += ps;
      s[c][0] = p0; s[c][1] = p1;
      pb[c] = pack_p(s[c][0], s[c][1]);
    }
    pv_half<NC>(Vl + hf * 64, LDS_ROW, pb, o, idx, quad);
    if (NC > 2) SCHED_BARRIER();
  }
}

struct Ctx {
  bf16_t *proj, *mixed, *qm, *vslcT, *vwinT, *xb, *kn, *retvT, *mlavT, *hid, *kc, *vcT, *u;
  float* rope; float* c1; unsigned* ctr;
  bf16_t *win, *wout, *wup, *wdown, *w1, *w2, *wuq, *wukv;
};

DEVI void nsa_item(const Ctx& cx, const unsigned* cflag, int b, int g, int qt, unsigned char* lds, int wv) {
  {
    const int lane0 = opaque_tid(wv);
  if (lane0 < 64) {
    if (lane0 == 0) { while (__hip_atomic_load(cflag + b, __ATOMIC_RELAXED, __HIP_MEMORY_SCOPE_AGENT) < 2u) __builtin_amdgcn_s_sleep(2); }
    __builtin_amdgcn_fence(__ATOMIC_ACQUIRE, "agent");
    asm volatile("s_waitcnt vmcnt(0)" ::: "memory");
  }
  __syncthreads();
  }
  const int tid = opaque_tid(wv), lane = tid & 63, wave = tid >> 6, idx = lane & 15, quad = lane >> 4;
  const int t0 = qt * 128;
  const int tq = t0 + wave * 16 + idx;
  const unsigned tokrow = (unsigned)(b * S + tq);
  const bf16_t* proj = cx.proj;
  const int lc = tid & 7, lr = tid >> 3;
  f32x4* const scrb = (f32x4*)cx.xb; const unsigned scro = ((unsigned)(blockIdx.x * 8 + wave) * 64u + (unsigned)lane) * 12u;
#define scr (scrb + scro)
  bf16x8 q[3][2];
#pragma unroll
  for (int c = 0; c < 3; ++c)
#pragma unroll
    for (int ks = 0; ks < 2; ++ks) q[c][ks] = *(const bf16x8*)(proj + (size_t)tokrow * PS + C_Q + (g * 3 + c) * 64 + ks * 32 + quad * 8);
  f32x4 o[3][4];
  float mr[3], lrn[3];
#pragma unroll
  for (int c = 0; c < 3; ++c) {
    mr[c] = -1e30f; lrn[c] = 0.f;
#pragma unroll
    for (int d = 0; d < 4; ++d) o[c][d] = (f32x4){0.f, 0.f, 0.f, 0.f};
  }
  float* impA = (float*)(lds + ATT_IMPA); float* impB = (float*)(lds + ATT_IMPB);
  unsigned* selm = (unsigned*)(lds + ATT_SELM); unsigned* bmaskp = (unsigned*)(lds + ATT_BMASK);
#pragma unroll
  for (int kt64 = 0; kt64 < 2; ++kt64) {
    u32x4 kr = *(const u32x4*)(cx.kc + ((size_t)((b * 128 + kt64 * 64 + lr) * 2 + g)) * 64 + lc * 8);
    u32x4 vr = *(const u32x4*)(cx.vcT + ((size_t)((b * 2 + g) * 64 + lr)) * 128 + kt64 * 64 + lc * 8);
    *(u32x4*)(lds + ATT_K0 + kt64 * ATT_KSZ + lr * LDS_ROW + lc * 16) = kr;
    *(u32x4*)(lds + ATT_V0 + kt64 * ATT_VSZ + lr * LDS_ROW + lc * 16) = vr;
  }
  if (tid == 0) *bmaskp = 0u;
  __syncthreads();
  const int wave_tmax = t0 + wave * 16 + 15, wave_tmin = t0 + wave * 16;
  const int nval = tq >= 31 ? ((tq - 31) >> 4) + 1 : 0;
  const int nval_w = wave_tmax >= 31 ? ((wave_tmax - 31) >> 4) + 1 : 0;
#pragma unroll 1
  for (int h32 = 0; h32 < 4; ++h32) {
    if (h32 * 32 < nval_w) {
      f32x4 s[3][2];
      qk_half<3, 2>(lds + ATT_K0 + (h32 >> 1) * ATT_KSZ + (h32 & 1) * 32 * LDS_ROW, LDS_ROW, q, s, idx, quad);
#pragma unroll
      for (int c = 0; c < 3; ++c) {
        float mx = -1e30f;
#pragma unroll
        for (int u = 0; u < 2; ++u)
#pragma unroll
          for (int j = 0; j < 4; ++j) { int n = h32 * 32 + u * 16 + quad * 4 + j; float v = (n < nval) ? s[c][u][j] : -1e30f; s[c][u][j] = v; mx = fmaxf(mx, v); }
        mx = fmaxf(mx, shx<16>(mx)); mx = fmaxf(mx, shx32(mx, quad * 16 + idx));
        const float mnew = fmaxf(mr[c], mx);
        float ps = 0.f;
#pragma unroll
        for (int u = 0; u < 2; ++u)
#pragma unroll
          for (int j = 0; j < 4; ++j) { float v = s[c][u][j]; ps += (v > -1e29f) ? fexp2(v - mnew) : 0.f; }
        ps += shx<16>(ps); ps += shx32(ps, quad * 16 + idx);
        lrn[c] = lrn[c] * fexp2(mr[c] - mnew) + ps; mr[c] = mnew;
      }
    }
  }
  float invl[3];
#pragma unroll
  for (int c = 0; c < 3; ++c) invl[c] = lrn[c] > 0.f ? 1.f / lrn[c] : 0.f;
  const int tl = wave * 16 + idx;
#pragma unroll 1
  for (int h32 = 0; h32 < 4; ++h32) {
    if (h32 * 32 < nval_w) {
      f32x4 s[3][2];
      qk_half<3, 2>(lds + ATT_K0 + (h32 >> 1) * ATT_KSZ + (h32 & 1) * 32 * LDS_ROW, LDS_ROW, q, s, idx, quad);
      bf16x8 pb[3];
#pragma unroll
      for (int c = 0; c < 3; ++c) {
#pragma unroll
        for (int u = 0; u < 2; ++u)
#pragma unroll
          for (int j = 0; j < 4; ++j) { int n = h32 * 32 + u * 16 + quad * 4 + j; s[c][u][j] = (n < nval) ? fexp2(s[c][u][j] - mr[c]) * invl[c] : 0.f; }
        pb[c] = pack_p(s[c][0], s[c][1]);
      }
      pv_half<3>(lds + ATT_V0 + (h32 >> 1) * ATT_VSZ + (h32 & 1) * 64, LDS_ROW, pb, o, idx, quad);
#pragma unroll
      for (int u = 0; u < 2; ++u) {
        float p0 = s[0][u][0] + s[1][u][0] + s[2][u][0], p1 = s[0][u][1] + s[1][u][1] + s[2][u][1];
        float p2 = s[0][u][2] + s[1][u][2] + s[2][u][2], p3 = s[0][u][3] + s[1][u][3] + s[2][u][3];
        const int mi = (h32 * 2 + u) * 4 + quad;
        impA[tl * 33 + mi] = p0 + p1 + p2 + 0.5f * p3;
        impB[tl * 33 + mi] = 0.5f * p3;
      }
    } else {
#pragma unroll
      for (int u = 0; u < 2; ++u) { const int mi = (h32 * 2 + u) * 4 + quad; impA[tl * 33 + mi] = 0.f; impB[tl * 33 + mi] = 0.f; }
    }
  }
  {
    const bf16_t* gp = proj + (size_t)(tokrow * (unsigned)PS + (unsigned)(C_GATE + g * 9));
#pragma unroll
    for (int c = 0; c < 3; ++c) {
      const float gt = sigmoidf(bf2f(gp[c * 3 + 0]));
#pragma unroll
      for (int d = 0; d < 4; ++d) { scr[c * 4 + d] = o[c][d] * gt; o[c][d] = (f32x4){0.f, 0.f, 0.f, 0.f}; }
      mr[c] = -1e29f; lrn[c] = 0.f;
    }
  }
  __syncthreads();
  {
    const int tl2 = tid >> 2, sub = tid & 3;
    const int cur = (t0 + tl2) >> 6;
    float a[32];
#pragma unroll
    for (int j = 0; j < 32; ++j) {
      float raw = impA[tl2 * 33 + j] + (j > 0 ? impB[tl2 * 33 + j - 1] : 0.f);
      bool valid = j <= cur, forced = (j == 0) | (j == cur) | (j == cur - 1);
      a[j] = valid ? (forced ? 1e9f : raw) : -1e30f;
    }
    unsigned bits = 0u;
#pragma unroll
    for (int e = 0; e < 8; ++e) {
      const int m = sub * 8 + e;
      float raw = impA[tl2 * 33 + m] + (m > 0 ? impB[tl2 * 33 + m - 1] : 0.f);
      bool valid = m <= cur, forced = (m == 0) | (m == cur) | (m == cur - 1);
      const float am = valid ? (forced ? 1e9f : raw) : -1e30f;
      int rank = 0;
#pragma unroll
      for (int j = 0; j < 32; ++j) rank += (a[j] > am || (a[j] == am && j < m)) ? 1 : 0;
      if (rank < 16 && valid) bits |= 1u << m;
    }
    bits |= shxu<1>(bits); bits |= shxu<2>(bits);
    if (sub == 0) { selm[tl2] = bits; atomicOr(bmaskp, bits); }
  }
  __syncthreads();
#pragma unroll
  for (int c = 0; c < 3; ++c)
#pragma unroll
    for (int ks = 0; ks < 2; ++ks) q[c][ks] = *(const bf16x8*)(proj + (size_t)tokrow * PS + C_Q + (g * 3 + c) * 64 + ks * 32 + quad * 8);
  const unsigned msel = selm[wave * 16 + idx];
  const unsigned bmask = *bmaskp;
  unsigned wmask = msel;
  wmask |= shxu<1>(wmask); wmask |= shxu<2>(wmask); wmask |= shxu<4>(wmask); wmask |= shxu<8>(wmask);
  unsigned wand = msel;
  wand &= shxu<1>(wand); wand &= shxu<2>(wand); wand &= shxu<4>(wand); wand &= shxu<8>(wand);
  const int mhi = 2 * qt + 1, wlo = (2 * qt - 8) > 0 ? (2 * qt - 8) : 0;
  unsigned long long winbits = ((mhi >= 31) ? 0xffffffffull : ((1ull << (mhi + 1)) - 1ull)) & ~((1ull << wlo) - 1ull);
  unsigned long long todo = (unsigned long long)bmask | (winbits << 32);
  bool in_win = false;
  u32x4 kr, vr;
  auto gload = [&](int e) {
    const int m = e & 31;
    const bf16_t* kp = proj + ((size_t)(b * S + m * 64 + lr)) * PS + (e < 32 ? C_KSLC : C_KWIN) + g * 64 + lc * 8;
    const bf16_t* vp = (e < 32 ? cx.vslcT : cx.vwinT) + ((size_t)((b * 2 + g) * 64 + lr)) * S + m * 64 + lc * 8;
    kr = *(const u32x4*)kp; vr = *(const u32x4*)vp;
  };
  auto lwrite = [&](int bi) {
    *(u32x4*)(lds + ATT_K0 + bi * ATT_KSZ + lr * LDS_ROW + lc * 16) = kr;
    *(u32x4*)(lds + ATT_V0 + bi * ATT_VSZ + lr * LDS_ROW + lc * 16) = vr;
  };
  int bi = 0;
  gload(__ffsll((long long)todo) - 1);
  lwrite(0);
  __syncthreads();
#pragma unroll 1
  while (todo) {
    const int e = __ffsll((long long)todo) - 1;
    todo &= todo - 1;
    const int en = todo ? (__ffsll((long long)todo) - 1) : -1;
    if (en >= 0) gload(en);
    const int m = e & 31;
    const bool is_win = e >= 32;
    if (is_win && !in_win) {
      in_win = true;
      const bf16_t* gp = proj + (size_t)(tokrow * (unsigned)PS + (unsigned)(C_GATE + g * 9));
#pragma unroll
      for (int c = 0; c < 3; ++c) {
        float lt = lrn[c]; lt += shx<16>(lt); lt += shx32(lt, quad * 16 + idx);
        const float gt = sigmoidf(bf2f(gp[c * 3 + 1])) * (lt > 0.f ? 1.f / lt : 0.f);
#pragma unroll
        for (int d = 0; d < 4; ++d) { scr[c * 4 + d] += o[c][d] * gt; o[c][d] = (f32x4){0.f, 0.f, 0.f, 0.f}; }
        mr[c] = -1e29f; lrn[c] = 0.f;
      }
    }
    const int kbase = m * 64;
    const bool active = is_win ? (kbase <= wave_tmax && kbase + 63 > wave_tmin - 512) : (((wmask >> m) & 1u) != 0u);
    if (active) {
      const int lo = is_win ? tq - 512 : -1;
      const bool selb = is_win ? true : (((msel >> m) & 1u) != 0u);
      const bool need = is_win ? ((kbase + 63 > wave_tmin) || (kbase <= wave_tmax - 512)) : (!((wand >> m) & 1u) || (kbase + 63 > wave_tmin));
      attn_tile<3, 2>(lds + ATT_K0 + bi * ATT_KSZ, LDS_ROW, lds + ATT_V0 + bi * ATT_VSZ, q, o, mr, lrn, idx, quad, need,
                      [&](int, int key) { const int kp = kbase + key; return selb && (kp <= tq) && (kp > lo); });
    }
    if (en >= 0) lwrite(bi ^ 1);
    __syncthreads();
    bi ^= 1;
  }
  {
    const bf16_t* gp = proj + (size_t)(tokrow * (unsigned)PS + (unsigned)(C_GATE + g * 9));
#pragma unroll
    for (int c = 0; c < 3; ++c) {
      float lt = lrn[c]; lt += shx<16>(lt); lt += shx32(lt, quad * 16 + idx);
      const float gt = sigmoidf(bf2f(gp[c * 3 + 2])) * (lt > 0.f ? 1.f / lt : 0.f);
#pragma unroll
      for (int d = 0; d < 4; ++d) store_bf4(cx.mixed + (size_t)(tokrow * (unsigned)DM + (unsigned)((g * 3 + c) * 64 + d * 16 + quad * 4)), scr[c * 4 + d] + o[c][d] * gt);
    }
  }
}

#undef scr
DEVI void mla_item(const Ctx& cx, int b, int h, int qt, unsigned char* lds, int wv) {
  const int tid = opaque_tid(wv), lane = tid & 63, wave = tid >> 6, idx = lane & 15, quad = lane >> 4;
  const int t0 = qt * 256;
  const int lc = tid & 7, lr = tid >> 3;
  const int lc2 = tid & 3, lr2 = (tid >> 2) & 63;
  int tq[2];
  bf16x8 q[2][3];
  f32x4 o[2][4]; float mr[2], lrn[2];
#pragma unroll
  for (int c = 0; c < 2; ++c) {
    tq[c] = t0 + wave * 32 + c * 16 + idx;
#pragma unroll
    for (int ks = 0; ks < 3; ++ks) q[c][ks] = *(const bf16x8*)(cx.qm + ((size_t)(b * S + tq[c])) * 512 + h * 96 + ks * 32 + quad * 8);
    mr[c] = -1e29f; lrn[c] = 0.f;
#pragma unroll
    for (int d = 0; d < 4; ++d) o[c][d] = (f32x4){0.f, 0.f, 0.f, 0.f};
  }
  const int wave_tmax = t0 + wave * 32 + 31;
  const int ntiles = 4 * qt + 4;
  u32x4 kr, vr, pr;
  auto gload = [&](int m) {
    kr = *(const u32x4*)(cx.kn + ((size_t)(b * S + m * 64 + lr)) * 320 + h * 64 + lc * 8);
    vr = *(const u32x4*)(cx.mlavT + ((size_t)((b * 5 + h) * 64 + lr)) * S + m * 64 + lc * 8);
    if (tid < 256) pr = *(const u32x4*)(cx.proj + ((size_t)(b * S + m * 64 + lr2)) * PS + C_KPE + lc2 * 8);
  };
  auto lwrite = [&](int bi) {
    *(u32x4*)(lds + ATT_K0 + bi * ATT_KSZ + lr * KROW_MLA + lc * 16) = kr;
    *(u32x4*)(lds + ATT_V0 + bi * ATT_VSZ + lr * LDS_ROW + lc * 16) = vr;
    if (tid < 256) *(u32x4*)(lds + ATT_K0 + bi * ATT_KSZ + lr2 * KROW_MLA + 128 + lc2 * 16) = pr;
  };
  gload(0); lwrite(0);
  __syncthreads();
  int bi = 0;
#pragma unroll 1
  for (int m = 0; m < ntiles; ++m) {
    if (m + 1 < ntiles) gload(m + 1);
    const int kbase = m * 64;
    if (kbase <= wave_tmax) {
      attn_tile<2, 3>(lds + ATT_K0 + bi * ATT_KSZ, KROW_MLA, lds + ATT_V0 + bi * ATT_VSZ, q, o, mr, lrn, idx, quad, kbase + 63 > t0 + wave * 32,
                      [&](int c, int key) { return kbase + key <= tq[c]; });
    }
    if (m + 1 < ntiles) lwrite(bi ^ 1);
    __syncthreads();
    bi ^= 1;
  }
#pragma unroll
  for (int c = 0; c < 2; ++c) {
    float lt = lrn[c]; lt += shx<16>(lt); lt += shx32(lt, quad * 16 + idx);
    const float il = lt > 0.f ? 1.f / lt : 0.f;
#pragma unroll
    for (int d = 0; d < 4; ++d) store_bf4(cx.mixed + ((size_t)(b * S + tq[c])) * DM + 384 + h * 64 + d * 16 + quad * 4, o[c][d] * il);
  }
}

DEVI void ret_item(const Ctx& cx, const float* __restrict__ gn, const float* __restrict__ xfl, const float* __restrict__ g1, const float* __restrict__ winl, int b, int h, unsigned char* lds, int wv) {
  const int tid = opaque_tid(wv), lane = tid & 63, wave = tid >> 6, idx = lane & 15, quad = lane >> 4;
  const float lg = log2f(1.f - exp2f(-5.f - (float)h));
  const int lc = tid & 7, lr = tid >> 3;
  const int vc = tid & 15, vrw = tid >> 4;
  f32x4 st[2];
  st[0] = (f32x4){0.f, 0.f, 0.f, 0.f}; st[1] = (f32x4){0.f, 0.f, 0.f, 0.f};
  const int et = wave >> 1, dt0 = (wave & 1) * 2;
  const float cdecay = fexp2(128.f * lg);
  const int i = wave * 16 + idx;
#pragma unroll 1
  for (int ci = 0; ci < 16; ++ci) {
    const int s0 = ci * 128;
    u32x4 kr[2], vr[2];
#pragma unroll
    for (int r = 0; r < 2; ++r) {
      kr[r] = *(const u32x4*)(cx.proj + ((size_t)(b * S + s0 + lr + 64 * r)) * PS + C_RK + h * 64 + lc * 8);
      vr[r] = *(const u32x4*)(cx.retvT + ((size_t)((b * 5 + h) * 64 + vrw + 32 * r)) * S + s0 + vc * 8);
    }
    const size_t tokrow = (size_t)(b * S + s0 + i);
    bf16x8 q[2];
#pragma unroll
    for (int ks = 0; ks < 2; ++ks) q[ks] = *(const bf16x8*)(cx.proj + tokrow * PS + C_RQ + h * 64 + ks * 32 + quad * 8);
    __syncthreads();
#pragma unroll
    for (int t = 0; t < 2; ++t)
#pragma unroll
      for (int j = 0; j < 4; ++j)
        *(bf16_t*)(lds + RET_ST + (et * 16 + quad * 4 + j) * LDS_ROW + ((dt0 + t) * 16 + idx) * 2) = f2bf(st[t][j]);
#pragma unroll
    for (int r = 0; r < 2; ++r) {
      const int row = lr + 64 * r;
      *(u32x4*)(lds + RET_KS + row * LDS_ROW + lc * 16) = kr[r];
      const float wd = fexp2((float)(127 - row) * lg);
#pragma unroll
      for (int e = 0; e < 4; ++e) {
        unsigned w = kr[r][e];
        float lo = __uint_as_float(w << 16) * wd, hi = __uint_as_float(w & 0xffff0000u) * wd;
        *(bf16_t*)(lds + RET_KWT + (lc * 8 + 2 * e) * RET_ROWT + row * 2) = f2bf(lo);
        *(bf16_t*)(lds + RET_KWT + (lc * 8 + 2 * e + 1) * RET_ROWT + row * 2) = f2bf(hi);
      }
      *(u32x4*)(lds + RET_VT + (vrw + 32 * r) * RET_ROWT + vc * 16) = vr[r];
    }
    __syncthreads();
    bf16x8 pb[4];
#pragma unroll
    for (int kc = 0; kc < 4; ++kc) {
      f32x4 s2[2];
#pragma unroll
      for (int u = 0; u < 2; ++u) {
        const int kt = 2 * kc + u;
        s2[u] = (f32x4){0.f, 0.f, 0.f, 0.f};
        if (kt <= wave) {
#pragma unroll
          for (int ks = 0; ks < 2; ++ks) {
            bf16x8 kf = *(const bf16x8*)(lds + RET_KS + (kt * 16 + idx) * LDS_ROW + ks * 64 + quad * 16);
            s2[u] = mfma16(kf, q[ks], s2[u]);
          }
#pragma unroll
          for (int j = 0; j < 4; ++j) { const int key = kt * 16 + quad * 4 + j; s2[u][j] = (key <= i) ? s2[u][j] * fexp2((float)(i - key) * lg) : 0.f; }
        }
      }
      pb[kc] = as_bf8((u32x4){pk2(s2[0][0], s2[0][1]), pk2(s2[0][2], s2[0][3]), pk2(s2[1][0], s2[1][1]), pk2(s2[1][2], s2[1][3])});
    }
    f32x4 o[4], oi[4];
#pragma unroll
    for (int dvt = 0; dvt < 4; ++dvt) {
      o[dvt] = (f32x4){0.f, 0.f, 0.f, 0.f}; oi[dvt] = (f32x4){0.f, 0.f, 0.f, 0.f};
#pragma unroll
      for (int kc = 0; kc < 4; ++kc) {
        if (2 * kc <= wave) {
          const unsigned char* p = lds + RET_VT + (dvt * 16 + idx) * RET_ROWT + kc * 64 + quad * 8;
          u32x2 lo = *(const u32x2*)p, hi = *(const u32x2*)(p + 32);
          o[dvt] = mfma16(as_bf8((u32x4){lo.x, lo.y, hi.x, hi.y}), pb[kc], o[dvt]);
        }
      }
#pragma unroll
      for (int ks = 0; ks < 2; ++ks) {
        bf16x8 sf = *(const bf16x8*)(lds + RET_ST + (dvt * 16 + idx) * LDS_ROW + ks * 64 + quad * 16);
        oi[dvt] = mfma16(sf, q[ks], oi[dvt]);
      }
    }
    const float rd = fexp2((float)(i + 1) * lg);
#pragma unroll
    for (int dvt = 0; dvt < 4; ++dvt) o[dvt] += oi[dvt] * rd;
#pragma unroll
    for (int t = 0; t < 2; ++t) {
      f32x4 nw = (f32x4){0.f, 0.f, 0.f, 0.f};
#pragma unroll
      for (int kc = 0; kc < 4; ++kc) {
        bf16x8 vf = *(const bf16x8*)(lds + RET_VT + (et * 16 + idx) * RET_ROWT + kc * 64 + quad * 16);
        bf16x8 kf = *(const bf16x8*)(lds + RET_KWT + ((dt0 + t) * 16 + idx) * RET_ROWT + kc * 64 + quad * 16);
        nw = mfma16(vf, kf, nw);
      }
      st[t] = st[t] * cdecay + nw;
    }
    float sum = 0.f;
#pragma unroll
    for (int dvt = 0; dvt < 4; ++dvt) sum += o[dvt][0] + o[dvt][1] + o[dvt][2] + o[dvt][3];
    sum += shx<16>(sum); sum += shx32(sum, quad * 16 + idx);
    const float mu = sum * (1.f / 64.f);
    float var = 0.f;
#pragma unroll
    for (int dvt = 0; dvt < 4; ++dvt)
#pragma unroll
      for (int j = 0; j < 4; ++j) { float d = o[dvt][j] - mu; var += d * d; }
    var += shx<16>(var); var += shx32(var, quad * 16 + idx);
    const float rstd = rsqrtf(var * (1.f / 64.f) + 1e-6f);
#pragma unroll
    for (int dvt = 0; dvt < 4; ++dvt) {
      const int dv = dvt * 16 + quad * 4;
      const u32x2 gw = *(const u32x2*)(cx.proj + tokrow * PS + C_RG + h * 64 + dv);
      const float4 gg = *(const float4*)(gn + h * 64 + dv);
      float gt[4] = {__uint_as_float(gw.x << 16), __uint_as_float(gw.x & 0xffff0000u), __uint_as_float(gw.y << 16), __uint_as_float(gw.y & 0xffff0000u)};
      float gnv[4] = {gg.x, gg.y, gg.z, gg.w};
      f32x4 r;
#pragma unroll
      for (int j = 0; j < 4; ++j) r[j] = (o[dvt][j] - mu) * rstd * gnv[j] * (gt[j] * sigmoidf(gt[j]));
      store_bf4(cx.mixed + tokrow * DM + 704 + h * 64 + dv, r);
    }
  }
  __syncthreads();
}

DEVI int next_item(unsigned* ctr, int* slot, int wv) {
  __syncthreads();
  if (opaque_tid(wv) == 0) *slot = (int)atomicAdd(ctr, 1u);
  __syncthreads();
  return *slot;
}


constexpr size_t WS_SH = 501 * MiB;
constexpr int SPW = 2880;
DEVI void sk_gemm(const float* __restrict__ A, int lda, int K, const float* __restrict__ W, int N, const float* __restrict__ gain,
                  bool use_rs, float* __restrict__ out, int ldo, int mode, unsigned char* lds, int wv, int bid, int nblk) {
  const int tid = opaque_tid(wv), lane = tid & 63, wave = tid >> 6, c16 = lane & 15, kq = lane >> 4;
  float* As = (float*)lds; float* red = (float*)(lds + 65536); float* rsS = (float*)(lds + 98304);
  const int ngrp = (N + 15) >> 4;
  for (int grp = bid; grp < ngrp; grp += nblk) {
    const int n = grp * 16 + c16; const int nl = n < N ? n : N - 1;
    float acc[16];
#pragma unroll
    for (int b = 0; b < 16; ++b) acc[b] = 0.f;
#pragma unroll 1
    for (int k0 = 0; k0 < K; k0 += 1024) {
      const int kc = (K - k0) < 1024 ? (K - k0) : 1024;
      __syncthreads();
      {
        const int b = tid >> 5, j = tid & 31; float ss = 0.f;
#pragma unroll 8
        for (int k = j; k < kc; k += 32) { const float v = A[(size_t)b * lda + k0 + k]; ss += v * v; As[b * 1024 + k] = v * gain[k0 + k]; }
        if (use_rs) { ss += shx<16>(ss); ss += shx<8>(ss); ss += shx<4>(ss); ss += shx<2>(ss); ss += shx<1>(ss); if (j == 0) rsS[b] = rsqrtf(ss / (float)K + 1e-6f); }
      }
      __syncthreads();
      const int ks = kc >> 5;
      const int kb = (wave * 4 + kq) * ks;
      const float* Wp = W + (size_t)(k0 + kb) * N + nl;
      const float* Ap = As + kb;
#pragma unroll 2
      for (int k = 0; k < ks; k += 4) {
        const float w0 = Wp[(size_t)(k + 0) * N], w1 = Wp[(size_t)(k + 1) * N], w2 = Wp[(size_t)(k + 2) * N], w3 = Wp[(size_t)(k + 3) * N];
#pragma unroll
        for (int b = 0; b < 16; ++b) { const float4 a = *(const float4*)(Ap + b * 1024 + k); acc[b] += a.x * w0 + a.y * w1 + a.z * w2 + a.w * w3; }
      }
    }
#pragma unroll
    for (int b = 0; b < 16; ++b) { float v = acc[b]; v += shx<16>(v); v += shx32(v, lane); if (kq == 0) red[(wave * 16 + b) * 16 + c16] = v; }
    __syncthreads();
    if (tid < 256) {
      const int b = tid >> 4, c = tid & 15; float v = 0.f;
#pragma unroll
      for (int w = 0; w < 8; ++w) v += red[(w * 16 + b) * 16 + c];
      const int nn = grp * 16 + c;
      if (nn < N) {
        if (use_rs) v *= rsS[b];
        float* o = out + (size_t)b * ldo + nn;
        if (mode == 1) *o += v; else if (mode == 2) { v = fmaxf(v, 0.f); *o = v * v; } else *o = v;
      }
    }
    __syncthreads();
  }
}
DEVI float sig_acc(float x) { return 1.f / (1.f + expf(-x)); }
DEVI void sk_mixer(const Params& p, int l, const float* __restrict__ SP, float* __restrict__ SM, int b, unsigned char* lds, int wv) {
  const int tid = opaque_tid(wv);
  const float* P = SP + (size_t)b * SPW; float* M = SM + (size_t)b * 1024;
  float* tmp = (float*)lds;
  __syncthreads();
  if (tid < 384) { const int hh = tid >> 6, d = tid & 63, g = hh / 3; M[tid] = sig_acc(P[1152 + hh * 3 + 1]) * P[768 + g * 64 + d] + sig_acc(P[1152 + hh * 3 + 2]) * P[1024 + g * 64 + d]; }
  if (tid < 128) tmp[tid] = P[1426 + tid];
  __syncthreads();
  if (tid == 0) { float ss = 0.f; for (int c = 0; c < 128; ++c) ss += tmp[c] * tmp[c]; tmp[128] = rsqrtf(ss * (1.f / 128.f) + 1e-6f); }
  if (tid >= 320 && tid < 325) { const int h = tid - 320; float sd = 0.f; for (int d = 0; d < 64; ++d) sd += P[1586 + h * 64 + d] * P[1906 + h * 64 + d]; tmp[136 + h] = sd * 0.125f; }
  __syncthreads();
  if (tid < 320) {
    const int h = tid >> 6, d = tid & 63;
    const float* w = p.in[13] + (size_t)l * 128 * 640; const float* kn = p.in[12] + (size_t)l * 128;
    float a = 0.f; for (int k = 0; k < 128; ++k) a += tmp[k] * kn[k] * w[(size_t)k * 640 + h * 128 + 64 + d];
    M[384 + tid] = a * tmp[128];
    const float s00 = tmp[136 + h];
    float mu = 0.f; for (int e = 0; e < 64; ++e) mu += P[2226 + h * 64 + e]; mu *= s00 * (1.f / 64.f);
    float var = 0.f; for (int e = 0; e < 64; ++e) { const float dd = s00 * P[2226 + h * 64 + e] - mu; var += dd * dd; } var *= (1.f / 64.f);
    const float gt = P[2546 + h * 64 + d];
    M[704 + tid] = (s00 * P[2226 + h * 64 + d] - mu) * rsqrtf(var + 1e-6f) * p.in[14][(size_t)l * 320 + h * 64 + d] * (gt * sig_acc(gt));
  }
  __syncthreads();
}

namespace pg8 {
#define PG8_LAS __attribute__((address_space(3)))
typedef unsigned short bf16_t;
typedef short bf16x8 __attribute__((ext_vector_type(8)));
typedef float f32x4 __attribute__((ext_vector_type(4)));
typedef unsigned u32x4 __attribute__((ext_vector_type(4)));
constexpr int BM = 256, BK = 64, HALF = 128, HTB = HALF * BK * 2  , STAGE_BYTES = 8 * HTB, NXCD = 8, WGM = 8;

__host__ __device__ __forceinline__ int lds_byte(int r, int c) { const int st = (r >> 4) * 2 + (c >> 5), rr = r & 15, cc = c & 31, ob = rr * 64 + cc * 2; return st * 1024 + (ob ^ (((ob >> 9) & 1) << 5)); }
__host__ __device__ __forceinline__ void stage_rc(int b, int& R, int& C) { const int st = b / 1024, sb = b % 1024, swz = sb ^ (((sb >> 9) & 1) << 5); R = (st >> 1) * 16 + swz / 64; C = (st & 1) * 32 + (swz % 64) / 2; }
__host__ __device__ __forceinline__ int perm32(int rho) { const int n = rho >> 4, i = rho & 15; return 8 * (i >> 2) + 4 * n + (i & 3); }

struct Unit { int pm, pn; };
struct Gemm { const bf16_t* A; const bf16_t* Bt; int M, N, K; };

struct StaticOrder {
    int nM, nN, nwg, G, c;
    __host__ __device__ void init(int M, int N, int G_, int c_) { nM = M / BM; nN = N / BM; nwg = nM * nN; G = G_; c = c_; }
    __host__ __device__ bool next(int i, Unit& u) const {
        const long L = (long)i * G + c; if (L >= nwg) return false;
        int wgid = (int)L; { const int q = nwg / NXCD, r = nwg % NXCD, xcd = wgid % NXCD, off = wgid / NXCD; wgid = (xcd < r ? xcd * (q + 1) : r * (q + 1) + (xcd - r) * q) + off; }
        const int nig = WGM * nN, gid = wgid / nig, fm = gid * WGM, gsz = (nM - fm) < WGM ? (nM - fm) : WGM;
        u.pm = fm + ((wgid % nig) % gsz); u.pn = (wgid % nig) / gsz; return true;
    }
    __device__ __forceinline__ void a_ready(const Unit&) const {}
    __device__ __forceinline__ void done(const Unit&) const {}
};
template <class Epi, class Sched, bool ALIGN_EPI = false, bool SP2 = false>
__device__ __forceinline__ void gemm_phase(PG8_LAS unsigned char* lds, const Gemm g, const Sched& S, const Epi& E, int tid_in) {
    const int tid = tid_in, wid = __builtin_amdgcn_readfirstlane(tid >> 6), lane = tid & 63, wr = wid >> 2, wc = wid & 3, fr = lane & 15, fq = lane >> 4;
    const int K = g.K, nt = K / BK;
    unsigned voffA[2], voffB[2];
#pragma unroll
    for (int i = 0; i < 2; ++i) { int R, C; stage_rc(tid * 16 + i * 8192, R, C); const int Rb = Epi::PERM ? ((R & ~31) + perm32(R & 31)) : R;
        voffA[i] = (unsigned)(R * K + C) * 2u; voffB[i] = (unsigned)(Rb * K + C) * 2u; }
    const size_t kstep = (size_t)(BK * 2);
    const size_t hstep = (size_t)HALF * K * 2;
    const size_t tstep = 2 * hstep;
    const unsigned ldsw = (unsigned)wid * 1024u;
    const int aoff = lds_byte(wr * 64 + fr, fq * 8), boff = lds_byte(wc * 32 + fr, fq * 8);
#define PG8_SA(b, h) (((b) * 2 + (h)) * HTB)
#define PG8_SB(b, h) ((4 + (b) * 2 + (h)) * HTB)
#define PG8_STAGE(bufoff, gbase, voff) do { _Pragma("unroll") for (int _i = 0; _i < 2; ++_i) \
        __builtin_amdgcn_global_load_lds((const unsigned*)((const char*)(gbase) + (voff)[_i]), (PG8_LAS unsigned*)(lds + (bufoff) + ldsw + _i * 8192), 16, 0, 0); } while (0)
#define PG8_LDA(dst, b, h) do { _Pragma("unroll") for (int m = 0; m < 4; ++m) _Pragma("unroll") for (int k = 0; k < 2; ++k) dst[m][k] = *(const PG8_LAS bf16x8*)(lds + PG8_SA(b, h) + aoff + m * 2048 + k * 1024); } while (0)
#define PG8_LDB(dst, b, h) do { _Pragma("unroll") for (int n = 0; n < 2; ++n) _Pragma("unroll") for (int k = 0; k < 2; ++k) dst[n][k] = *(const PG8_LAS bf16x8*)(lds + PG8_SB(b, h) + boff + n * 2048 + k * 1024); } while (0)
#define PG8_MMA(ai, bj, At, Bt) do { __builtin_amdgcn_s_setprio(1); _Pragma("unroll") for (int m = 0; m < 4; ++m) _Pragma("unroll") for (int n = 0; n < 2; ++n) _Pragma("unroll") for (int k = 0; k < 2; ++k) \
        acc[ai][bj][m][n] = __builtin_amdgcn_mfma_f32_16x16x32_bf16(Bt[n][k], At[m][k], acc[ai][bj][m][n], 0, 0, 0); __builtin_amdgcn_s_setprio(0); } while (0)
#define PG8_WAIT_V(n) asm volatile("s_waitcnt vmcnt(" #n ")" ::: "memory")
#define PG8_WAIT_L(n) asm volatile("s_waitcnt lgkmcnt(" #n ")" ::: "memory")
#define PG8_BAR __builtin_amdgcn_s_barrier()
#define PG8_SCHED __builtin_amdgcn_sched_barrier(0)
    Unit cur, nxt; int ui = 0;
    if (!S.next(0, cur)) return;
    f32x4 acc[2][2][4][2];
#pragma unroll
    for (int a = 0; a < 2; ++a)
#pragma unroll
        for (int b = 0; b < 2; ++b)
#pragma unroll
            for (int m = 0; m < 4; ++m)
#pragma unroll
                for (int n = 0; n < 2; ++n) acc[a][b][m][n] = (f32x4){0.f, 0.f, 0.f, 0.f};
    bf16x8 At[4][2], B0[2][2], B1[2][2];
    const char* cA = (const char*)g.A + (size_t)cur.pm * tstep; const char* cB = (const char*)g.Bt + (size_t)cur.pn * tstep;
    S.a_ready(cur);
    if constexpr (SP2) {
        PG8_STAGE(PG8_SB(0, 0), cB, voffB); PG8_STAGE(PG8_SB(0, 1), cB + hstep, voffB); PG8_STAGE(PG8_SA(0, 0), cA, voffA); PG8_STAGE(PG8_SA(0, 1), cA + hstep, voffA);
        if (wr == 1) PG8_BAR;
        PG8_WAIT_V(2); PG8_BAR;
        PG8_STAGE(PG8_SB(1, 0), cB + kstep, voffB); PG8_STAGE(PG8_SA(1, 0), cA + kstep, voffA); PG8_STAGE(PG8_SB(1, 1), cB + hstep + kstep, voffB);
        PG8_WAIT_V(6); PG8_BAR;
    } else {
        PG8_STAGE(PG8_SB(0, 0), cB, voffB); PG8_STAGE(PG8_SA(0, 0), cA, voffA); PG8_STAGE(PG8_SB(0, 1), cB + hstep, voffB); PG8_STAGE(PG8_SA(0, 1), cA + hstep, voffA);
        if (wr == 1) PG8_BAR;
        PG8_WAIT_V(4); PG8_BAR;
        PG8_STAGE(PG8_SB(1, 0), cB + kstep, voffB); PG8_STAGE(PG8_SA(1, 0), cA + kstep, voffA); PG8_STAGE(PG8_SB(1, 1), cB + hstep + kstep, voffB);
        PG8_WAIT_V(6); PG8_BAR;
    }
    for (;;) {
        const bool has_next = S.next(ui + 1, nxt);
        const char* nA = has_next ? (const char*)g.A + (size_t)nxt.pm * tstep : cA; const char* nB = has_next ? (const char*)g.Bt + (size_t)nxt.pn * tstep : cB;
        for (int t = 0; t < nt; t += 2) {
            const bool last = (t == nt - 2);
            const char* a1 = cA + (size_t)(t + 1) * kstep;
            const char* a2 = last ? nA : cA + (size_t)(t + 2) * kstep; const char* b2 = last ? nB : cB + (size_t)(t + 2) * kstep;
            const char* a3 = a2 + kstep; const char* b3 = b2 + kstep;
            if (last && has_next) S.a_ready(nxt);
            if constexpr (SP2) {
            PG8_LDB(B0, 0, 0); PG8_LDB(B1, 0, 1); PG8_SCHED; PG8_LDA(At, 0, 0); PG8_STAGE(PG8_SA(1, 1), a1 + hstep, voffA);
            PG8_WAIT_V(8); PG8_WAIT_L(0); PG8_BAR; PG8_MMA(0, 0, At, B0); PG8_MMA(0, 1, At, B1); PG8_BAR; PG8_SCHED;
            PG8_LDA(At, 0, 1); PG8_STAGE(PG8_SB(0, 0), b2, voffB); PG8_STAGE(PG8_SB(0, 1), b2 + hstep, voffB); PG8_STAGE(PG8_SA(0, 0), a2, voffA);
            PG8_WAIT_V(8); PG8_WAIT_L(0); PG8_BAR; PG8_MMA(1, 0, At, B0); PG8_MMA(1, 1, At, B1); PG8_BAR; PG8_SCHED;
            PG8_LDB(B0, 1, 0); PG8_LDB(B1, 1, 1); PG8_SCHED; PG8_LDA(At, 1, 0); PG8_STAGE(PG8_SA(0, 1), a2 + hstep, voffA);
            PG8_WAIT_V(8); PG8_WAIT_L(0); PG8_BAR; PG8_MMA(0, 0, At, B0); PG8_MMA(0, 1, At, B1); PG8_BAR; PG8_SCHED;
            PG8_LDA(At, 1, 1); PG8_STAGE(PG8_SB(1, 0), b3, voffB); PG8_STAGE(PG8_SB(1, 1), b3 + hstep, voffB); PG8_STAGE(PG8_SA(1, 0), a3, voffA);
            PG8_WAIT_V(8); PG8_WAIT_L(0); PG8_BAR; PG8_MMA(1, 0, At, B0); PG8_MMA(1, 1, At, B1); PG8_BAR; PG8_SCHED;
            } else {
            PG8_LDB(B0, 0, 0); PG8_SCHED; PG8_LDA(At, 0, 0); PG8_STAGE(PG8_SA(1, 1), a1 + hstep, voffA);
            PG8_WAIT_L(8); PG8_BAR; PG8_WAIT_L(0); PG8_MMA(0, 0, At, B0); PG8_BAR; PG8_SCHED;
            PG8_LDB(B1, 0, 1); PG8_STAGE(PG8_SB(0, 0), b2, voffB);
            PG8_BAR; PG8_WAIT_L(0); PG8_MMA(0, 1, At, B1); PG8_BAR;
            PG8_LDA(At, 0, 1); PG8_STAGE(PG8_SA(0, 0), a2, voffA);
            PG8_BAR; PG8_WAIT_L(0); PG8_MMA(1, 0, At, B0); PG8_BAR; PG8_SCHED;
            PG8_STAGE(PG8_SB(0, 1), b2 + hstep, voffB);
            PG8_WAIT_V(6); PG8_BAR; PG8_MMA(1, 1, At, B1); PG8_BAR;
            PG8_LDB(B0, 1, 0); PG8_SCHED; PG8_LDA(At, 1, 0); PG8_STAGE(PG8_SA(0, 1), a2 + hstep, voffA);
            PG8_WAIT_L(8); PG8_BAR; PG8_WAIT_L(0); PG8_MMA(0, 0, At, B0); PG8_BAR; PG8_SCHED;
            PG8_LDB(B1, 1, 1); PG8_STAGE(PG8_SB(1, 0), b3, voffB);
            PG8_BAR; PG8_WAIT_L(0); PG8_MMA(0, 1, At, B1); PG8_BAR;
            PG8_LDA(At, 1, 1); PG8_STAGE(PG8_SA(1, 0), a3, voffA);
            PG8_BAR; PG8_WAIT_L(0); PG8_MMA(1, 0, At, B0); PG8_BAR; PG8_SCHED;
            PG8_STAGE(PG8_SB(1, 1), b3 + hstep, voffB);
            PG8_WAIT_V(6); PG8_BAR; PG8_MMA(1, 1, At, B1); PG8_BAR;
            }
        }
        if constexpr (ALIGN_EPI) { if (wr == 0) PG8_BAR; }
        if constexpr (!Epi::AFTER_DRAIN) { E(acc, cur, wr, wc, fr, fq); S.done(cur); }
        if (!has_next) break;
#pragma unroll
        for (int a = 0; a < 2; ++a)
#pragma unroll
            for (int b = 0; b < 2; ++b)
#pragma unroll
                for (int m = 0; m < 4; ++m)
#pragma unroll
                    for (int n = 0; n < 2; ++n) acc[a][b][m][n] = (f32x4){0.f, 0.f, 0.f, 0.f};
        cur = nxt; cA = nA; cB = nB; ++ui;
        if constexpr (ALIGN_EPI) { if (wr == 1) PG8_BAR; }
    }
    PG8_WAIT_V(0);
    if constexpr (!ALIGN_EPI) { if (wr == 0) PG8_BAR; }
    PG8_BAR;
    if constexpr (Epi::AFTER_DRAIN) { E.fused(acc, cur, wr, wc, fr, fq, lds, wid, lane); S.done(cur); }
#undef PG8_SA
#undef PG8_SB
#undef PG8_STAGE
#undef PG8_LDA
#undef PG8_LDB
#undef PG8_MMA
#undef PG8_WAIT_V
#undef PG8_WAIT_L
#undef PG8_BAR
#undef PG8_SCHED
}
}

template <class E> struct EpiAdapt {
  static constexpr bool PERM = false, AFTER_DRAIN = false;
  E e; const float* ssrow;
  DEVI void operator()(const f32x4 (&acc)[2][2][4][2], const pg8::Unit& u, int wr, int wc, int fr, int fq) const {
#pragma unroll
    for (int ai = 0; ai < 2; ++ai)
#pragma unroll
      for (int m = 0; m < 4; ++m) {
        const int row = u.pm * 256 + ai * 128 + wr * 64 + m * 16 + fr;
        float rs = 1.f;
        if (ssrow) {
          const float4* sp = (const float4*)(ssrow + (size_t)row * 16);
          const float4 a = sp[0], b = sp[1], c = sp[2], d = sp[3];
          const float ssum = (((a.x + a.y) + (a.z + a.w)) + ((b.x + b.y) + (b.z + b.w))) + (((c.x + c.y) + (c.z + c.w)) + ((d.x + d.y) + (d.z + d.w)));
          rs = rsqrtf(ssum * (1.f / 1024.f) + 1e-6f);
        }
#pragma unroll
        for (int bj = 0; bj < 2; ++bj)
#pragma unroll
          for (int n = 0; n < 2; ++n) e(row, u.pn * 256 + bj * 128 + wc * 32 + n * 16 + fq * 4, acc[ai][bj][m][n], rs);
      }
  }
};
struct EpiAdaptResid {
  static constexpr bool PERM = true, AFTER_DRAIN = false;
  float* xf; bf16_t* xb; float* ssout; const float* snap;
  DEVI void operator()(const f32x4 (&acc)[2][2][4][2], const pg8::Unit& u, int wr, int wc, int fr, int fq) const {
#pragma unroll
    for (int ai = 0; ai < 2; ++ai)
#pragma unroll
      for (int m = 0; m < 4; ++m) {
        const int row = u.pm * 256 + ai * 128 + wr * 64 + m * 16 + fr;
        const bool use_snap = snap && (row & 2047) == 0;
        float ss = 0.f;
#pragma unroll
        for (int bj = 0; bj < 2; ++bj) {
          const int col = u.pn * 256 + bj * 128 + wc * 32 + fq * 8;
          float* p = xf + (size_t)row * DM + col;
          f32x4 x0 = *(const f32x4*)p, x1 = *(const f32x4*)(p + 4);
          x0 += acc[ai][bj][m][0]; x1 += acc[ai][bj][m][1];
          if (use_snap) { const float* sp = snap + (size_t)(row >> 11) * 1024 + col; x0 = *(const f32x4*)sp; x1 = *(const f32x4*)(sp + 4); }
          *(f32x4*)p = x0; *(f32x4*)(p + 4) = x1;
          u32x4 w; w.x = pk2(x0[0], x0[1]); w.y = pk2(x0[2], x0[3]); w.z = pk2(x1[0], x1[1]); w.w = pk2(x1[2], x1[3]);
          *(u32x4*)(xb + (size_t)row * DM + col) = w;
          ss += (x0[0] * x0[0] + x0[1] * x0[1] + x0[2] * x0[2] + x0[3] * x0[3]) + (x1[0] * x1[0] + x1[1] * x1[1] + x1[2] * x1[2] + x1[3] * x1[3]);
        }
        ss += shx<16>(ss); ss += shx32(ss, fq * 16 + fr);
        if (fq == 0) ssout[(size_t)row * 16 + u.pn * 4 + wc] = ss;
      }
  }
};
struct EpiAdaptRelu2 {
  static constexpr bool PERM = true, AFTER_DRAIN = false;
  bf16_t* uo; const float* ssrow;
  DEVI void operator()(const f32x4 (&acc)[2][2][4][2], const pg8::Unit& u, int wr, int wc, int fr, int fq) const {
#pragma unroll
    for (int ai = 0; ai < 2; ++ai)
#pragma unroll
      for (int m = 0; m < 4; ++m) {
        const int row = u.pm * 256 + ai * 128 + wr * 64 + m * 16 + fr;
        const float4* sp = (const float4*)(ssrow + (size_t)row * 16);
        const float4 a = sp[0], b = sp[1], c = sp[2], d = sp[3];
        const float ssum = (((a.x + a.y) + (a.z + a.w)) + ((b.x + b.y) + (b.z + b.w))) + (((c.x + c.y) + (c.z + c.w)) + ((d.x + d.y) + (d.z + d.w)));
        const float rs = rsqrtf(ssum * (1.f / 1024.f) + 1e-6f);
#pragma unroll
        for (int bj = 0; bj < 2; ++bj) {
          const int col = u.pn * 256 + bj * 128 + wc * 32 + fq * 8;
          float h[8];
#pragma unroll
          for (int j = 0; j < 4; ++j) { const float h0 = fmaxf(acc[ai][bj][m][0][j] * rs, 0.f), h1 = fmaxf(acc[ai][bj][m][1][j] * rs, 0.f); h[j] = h0 * h0; h[4 + j] = h1 * h1; }
          u32x4 w; w.x = pk2(h[0], h[1]); w.y = pk2(h[2], h[3]); w.z = pk2(h[4], h[5]); w.w = pk2(h[6], h[7]);
          *(u32x4*)(uo + (size_t)row * DFF + col) = w;
        }
      }
  }
};


DEVI void gbar(unsigned* ctr, unsigned& gen, int wv) {
  asm volatile("s_waitcnt vmcnt(0) lgkmcnt(0)" ::: "memory");
  __syncthreads();
  ++gen;
  const int tb = opaque_tid(wv);
  if (tb < 64) {
    __builtin_amdgcn_fence(__ATOMIC_RELEASE, "agent");
    asm volatile("s_waitcnt vmcnt(0)" ::: "memory");
    if (tb == 0) {
      __hip_atomic_fetch_add(ctr, 1u, __ATOMIC_RELAXED, __HIP_MEMORY_SCOPE_AGENT);
      const unsigned target = gen * 256u;
      while (__hip_atomic_load(ctr, __ATOMIC_RELAXED, __HIP_MEMORY_SCOPE_AGENT) < target) __builtin_amdgcn_s_sleep(1);
    }
    __builtin_amdgcn_fence(__ATOMIC_ACQUIRE, "agent");
    asm volatile("s_waitcnt vmcnt(0)" ::: "memory");
  }
  __syncthreads();
}


struct EpiAdaptInProjPM {
  static constexpr bool PERM = true, AFTER_DRAIN = false;
  bf16_t* proj; bf16_t* vslcT; bf16_t* vwinT; bf16_t* retvT; const float* rope; const float* ssrow;
  DEVI f32x4 xform(int m, int n, f32x4 v, float rs) const {
    v *= rs;
    int ri = -1; float sc = 1.f;
    if (n < C_VCMP) { int d = n & 63; if (d < 16) ri = d >> 1; if (n < C_KCMP) sc = QSCALE_NSA; }
    else if (n < C_KSLC) {}
    else if (n < C_GATE) { int d = n & 63; if (d < 16) ri = d >> 1; }
    else if (n < C_KPE) {}
    else if (n < C_RQ) { ri = 8 + ((n - C_KPE) >> 1); }
    else if (n < C_RG) { int d = (n - C_RQ) & 63; ri = 24 + (d >> 1); if (n >= C_RK) sc = 0.125f; }
    if (ri >= 0) {
      const float4 cs = *(const float4*)(rope + ((size_t)m * 56 + ri) * 2);
      float a0 = v[0] * cs.x - v[1] * cs.y, a1 = v[1] * cs.x + v[0] * cs.y;
      float a2 = v[2] * cs.z - v[3] * cs.w, a3 = v[3] * cs.z + v[2] * cs.w;
      v = (f32x4){a0, a1, a2, a3};
    }
    return v * sc;
  }
  DEVI void operator()(const f32x4 (&acc)[2][2][4][2], const pg8::Unit& u, int wr, int wc, int fr, int fq) const {
#pragma unroll 1
    for (int ai = 0; ai < 2; ++ai)
#pragma unroll
      for (int m = 0; m < 4; ++m) {
        const int row = u.pm * 256 + ai * 128 + wr * 64 + m * 16 + fr;
        const float4* sp = (const float4*)(ssrow + (size_t)row * 16);
        const float4 a = sp[0], b = sp[1], c = sp[2], d = sp[3];
        const float ssum = (((a.x + a.y) + (a.z + a.w)) + ((b.x + b.y) + (b.z + b.w))) + (((c.x + c.y) + (c.z + c.w)) + ((d.x + d.y) + (d.z + d.w)));
        const float rs = rsqrtf(ssum * (1.f / 1024.f) + 1e-6f);
#pragma unroll
        for (int bj = 0; bj < 2; ++bj) {
          const int col = u.pn * 256 + bj * 128 + wc * 32 + fq * 8;
          const f32x4 a0 = ai ? acc[1][bj][m][0] : acc[0][bj][m][0], a1 = ai ? acc[1][bj][m][1] : acc[0][bj][m][1];
          if (u.pn < 9) {
            const f32x4 v0 = xform(row, col, a0, rs), v1 = xform(row, col + 4, a1, rs);
            u32x4 w; w.x = pk2(v0[0], v0[1]); w.y = pk2(v0[2], v0[3]); w.z = pk2(v1[0], v1[1]); w.w = pk2(v1[2], v1[3]);
            *(u32x4*)(proj + (size_t)row * PS + col) = w;
          } else if (col < C_END) {
            const int bb = row >> 11, sq = row & 2047;
            bf16_t* dst;
            if (col < C_VWIN) { const int e = col - C_VSLC; dst = vslcT + ((size_t)((bb * 2 + (e >> 6)) * 64 + (e & 63))) * S + sq; }
            else if (col < C_RV) { const int e = col - C_VWIN; dst = vwinT + ((size_t)((bb * 2 + (e >> 6)) * 64 + (e & 63))) * S + sq; }
            else { const int e = col - C_RV; dst = retvT + ((size_t)((bb * 5 + (e >> 6)) * 64 + (e & 63))) * S + sq; }
#pragma unroll
            for (int j = 0; j < 4; ++j) { dst[(size_t)j * S] = f2bf(a0[j] * rs); dst[(size_t)(j + 4) * S] = f2bf(a1[j] * rs); }
          }
        }
      }
  }
};

__global__ void __launch_bounds__(512) mega(Params p) {
  cg::grid_group grid = cg::this_grid();
  extern __shared__ __attribute__((aligned(16))) unsigned char lds[];
  constexpr int nblk = 256; const int bid = blockIdx.x;
  const int wv = __builtin_amdgcn_readfirstlane((int)(threadIdx.x >> 6));
  unsigned char* ws = p.ws;
  Ctx cx;
  cx.proj = (bf16_t*)(ws + WS_PROJ); cx.mixed = (bf16_t*)(ws + WS_MIXED); cx.qm = (bf16_t*)(ws + WS_QM);
  cx.vslcT = (bf16_t*)(ws + WS_VSLCT); cx.vwinT = (bf16_t*)(ws + WS_VWINT); cx.xb = (bf16_t*)(ws + WS_XB);
  cx.kn = (bf16_t*)(ws + WS_KN); cx.retvT = (bf16_t*)(ws + WS_RETVT); cx.mlavT = (bf16_t*)(ws + WS_MLAVT);
  cx.hid = (bf16_t*)(ws + WS_HID); cx.kc = (bf16_t*)(ws + WS_KC); cx.vcT = (bf16_t*)(ws + WS_VCT); cx.u = (bf16_t*)(ws + WS_U);
  cx.rope = (float*)(ws + WS_ROPE); cx.c1 = (float*)(ws + WS_C1); cx.ctr = (unsigned*)(ws + WS_CTR);
  cx.win = (bf16_t*)(ws + WS_WIN); cx.wout = (bf16_t*)(ws + WS_WOUT); cx.wup = (bf16_t*)(ws + WS_WUP); cx.wdown = (bf16_t*)(ws + WS_WDOWN);
  cx.w1 = (bf16_t*)(ws + WS_W1); cx.w2 = (bf16_t*)(ws + WS_W2); cx.wuq = (bf16_t*)(ws + WS_WUQ); cx.wukv = (bf16_t*)(ws + WS_WUKV);
  float* xf = p.out;
  int* slot = (int*)(lds + LDS_SLOT);

  {
    const int tid = opaque_tid(wv);
    if (bid == 0 && tid < 256) cx.ctr[tid] = 0u;
    float* lt = (float*)lds;
    for (int it = bid; it < 4 * 1630; it += nblk) {
      const int l = it / 1630; int r = it % 1630;
      const float* src; int ldsrc; bf16_t* dst; int K; const float* gain = nullptr; int kind; int kt, nt;
      if (r < 384) { kind = 0; src = p.in[3] + (size_t)l * 1024 * 2866; ldsrc = 2866; dst = cx.win + (size_t)l * NIN * 1024; K = 1024; gain = p.in[2] + l * 1024; kt = r / 24; nt = r % 24; }
      else if (r < 512) { r -= 384; kind = 1; src = p.in[15] + (size_t)l * 1024 * 1024; ldsrc = 1024; dst = cx.wout + (size_t)l * 1024 * 1024; K = 1024; kt = r / 8; nt = r % 8; }
      else if (r < 1024) { r -= 512; kind = 2; src = p.in[17] + (size_t)l * 1024 * 4096; ldsrc = 4096; dst = cx.wup + (size_t)l * 4096 * 1024; K = 1024; gain = p.in[16] + l * 1024; kt = r / 32; nt = r % 32; }
      else if (r < 1536) { r -= 1024; kind = 3; src = p.in[18] + (size_t)l * 4096 * 1024; ldsrc = 1024; dst = cx.wdown + (size_t)l * 1024 * 4096; K = 4096; kt = r / 8; nt = r % 8; }
      else if (r < 1568) { r -= 1536; kind = 4; src = p.in[5] + (size_t)l * 2048 * 128; ldsrc = 128; dst = cx.w1 + (size_t)(l * 2 + 0) * 128 * 2048; K = 2048; kt = r; nt = 0; }
      else if (r < 1600) { r -= 1568; kind = 5; src = p.in[8] + (size_t)l * 2048 * 128; ldsrc = 128; dst = cx.w1 + (size_t)(l * 2 + 1) * 128 * 2048; K = 2048; kt = r; nt = 0; }
      else if (r < 1602) { r -= 1600; kind = 6; src = p.in[6] + (size_t)l * 128 * 64; ldsrc = 64; dst = cx.w2 + (size_t)(l * 2 + 0) * 128 * 128; K = 128; kt = r; nt = 0; }
      else if (r < 1604) { r -= 1602; kind = 7; src = p.in[9] + (size_t)l * 128 * 64; ldsrc = 64; dst = cx.w2 + (size_t)(l * 2 + 1) * 128 * 128; K = 128; kt = r; nt = 0; }
      else if (r < 1620) { r -= 1604; kind = 8; src = p.in[11] + (size_t)l * 256 * 480; ldsrc = 480; dst = cx.wuq + (size_t)l * 512 * 256; K = 256; gain = p.in[10] + l * 256; kt = r / 4; nt = r % 4; }
      else { r -= 1620; kind = 9; src = p.in[13] + (size_t)l * 128 * 640; ldsrc = 640; dst = cx.wukv + (size_t)l * 640 * 128; K = 128; gain = p.in[12] + l * 128; kt = r / 5; nt = r % 5; }
      transpose_tile(src, ldsrc, dst, K, kt * 64, nt * 128, gain, kind, lt, wv);
    }
    {
      const int lane = tid & 63, wave = tid >> 6;
      float* ssB = (float*)(ws + WS_SS) + (size_t)T * 16;
      for (int row = bid * 8 + wave; row < T; row += nblk * 8) {
        const float* r = p.in[0] + (size_t)row * DM; float ss = 0.f;
#pragma unroll
        for (int j = 0; j < 4; ++j) {
          const float4 v = *(const float4*)(r + j * 256 + lane * 4);
          *(float4*)(xf + (size_t)row * DM + j * 256 + lane * 4) = v;
          u32x2 w; w.x = pk2(v.x, v.y); w.y = pk2(v.z, v.w);
          *(u32x2*)(cx.xb + (size_t)row * DM + j * 256 + lane * 4) = w;
          ss += v.x * v.x + v.y * v.y + v.z * v.z + v.w * v.w;
        }
        ss += shx32(ss, lane); ss += shx<16>(ss); ss += shx<8>(ss); ss += shx<4>(ss); ss += shx<2>(ss); ss += shx<1>(ss);
        if (lane < 16) ssB[(size_t)row * 16 + lane] = lane == 0 ? ss : 0.f;
      }
    }
    {
      const int* pos = (const int*)p.in[1];
      for (int e = bid * 512 + tid; e < T * 56; e += nblk * 512) {
        const int t = e / 56, f = e % 56;
        double ex;
        if (f < 8) ex = -(2.0 * f / 16.0) * 13.122363377404328;
        else if (f < 24) ex = -(2.0 * (f - 8) / 32.0) * 13.122363377404328;
        else ex = -(2.0 * (f - 24) / 64.0) * 9.210340371976184;
        const double inv = exp(ex);
        const double x = (double)pos[t] * inv;
        const double k = rint(x * 0.15915494309189535);
        const double r = x - k * 6.283185307179586;
        const double r2 = r * r;
        double term = 1.0, cs = 1.0, ts = r, sn = r;
#pragma unroll
        for (int n = 1; n <= 13; ++n) {
          term *= -r2 * (1.0 / (double)((2 * n - 1) * (2 * n))); cs += term;
          ts *= -r2 * (1.0 / (double)((2 * n) * (2 * n + 1))); sn += ts;
        }
        cx.rope[(size_t)e * 2] = (float)cs; cx.rope[(size_t)e * 2 + 1] = (float)sn;
      }
    }
    if (bid < 8) {
      const int l = bid >> 1, kv = bid & 1;
      const float* pos = p.in[kv ? 7 : 4] + (size_t)l * 2048;
      const float* w1 = p.in[kv ? 8 : 5] + (size_t)l * 2048 * 128;
      const int n = tid & 127, part = tid >> 7;
      float a = 0.f;
      for (int k = part * 512; k < part * 512 + 512; ++k) a += pos[k] * w1[(size_t)k * 128 + n];
      float* red = (float*)lds;
      __syncthreads();
      red[tid] = a;
      __syncthreads();
      if (tid < 128) cx.c1[(l * 2 + kv) * 128 + tid] = red[tid] + red[tid + 128] + red[tid + 256] + red[tid + 384];
      __syncthreads();
    }
  }
  grid.sync();
  float* SX = (float*)(ws + WS_SH); float* SPb = SX + 16 * 1024; float* SM = SPb + 16 * SPW; float* SU = SM + 16 * 1024; float* SNAP = SU + 16 * 4096;
  float* ONES = SNAP + 4 * 16 * 1024;
  {
    const int tid = opaque_tid(wv);
    if (bid < 16) { for (int k = tid; k < DM; k += 512) SX[bid * 1024 + k] = p.in[0][(size_t)bid * S * DM + k]; }
    if (bid == 16) { for (int k = tid; k < 4096; k += 512) ONES[k] = 1.f; }
  }
  int sph = 0;
  auto shadow_step = [&]() {
    int bido = bid; asm volatile("" : "+s"(bido));
    if (sph <= 20 && sph % 5 == 0 && sph > 0 && bido < 16) {
      const int tid = opaque_tid(wv);
      for (int k = tid; k < DM; k += 512) SNAP[(size_t)((sph / 5 - 1) * 16 + bido) * 1024 + k] = SX[bido * 1024 + k];
    }
    if (sph < 20) {
      const int l = sph / 5, st = sph % 5;
      if (st == 0) sk_gemm(SX, 1024, 1024, p.in[3] + (size_t)l * 1024 * 2866, 2866, p.in[2] + l * 1024, true, SPb, SPW, 0, lds, wv, bid, nblk);
      else if (st == 1) { if (bido >= 240) sk_mixer(p, l, SPb, SM, bido - 240, lds, wv); }
      else if (st == 2) sk_gemm(SM, 1024, 1024, p.in[15] + (size_t)l * 1024 * 1024, 1024, ONES, false, SX, 1024, 1, lds, wv, bid, nblk);
      else if (st == 3) sk_gemm(SX, 1024, 1024, p.in[17] + (size_t)l * 1024 * 4096, 4096, p.in[16] + l * 1024, true, SU, 4096, 2, lds, wv, bid, nblk);
      else sk_gemm(SU, 4096, 4096, p.in[18] + (size_t)l * 4096 * 1024, 1024, ONES, false, SX, 1024, 1, lds, wv, bid, nblk);
    }
    ++sph;
  };

  unsigned gen = 0; unsigned* barw = cx.ctr + 4096;
  gbar(barw, gen, wv);
#pragma unroll 1
  for (int l = 0; l < 4; ++l) {
    shadow_step();
    {
      float* ssB = (float*)(ws + WS_SS) + (size_t)T * 16;
      const int tid = opaque_tid(wv);
      EpiAdaptInProjPM ep{cx.proj, cx.vslcT, cx.vwinT, cx.retvT, cx.rope, ssB};
      pg8::Gemm g{cx.xb, cx.win + (size_t)l * NIN * 1024, T, NIN, 1024};
      pg8::StaticOrder so; so.init(T, NIN, nblk, bid);
      __syncthreads();
      pg8::gemm_phase<EpiAdaptInProjPM, pg8::StaticOrder, true, true>((PG8_LAS unsigned char*)lds, g, so, ep, tid);
      __syncthreads();
    }
    gbar(barw, gen, wv);
    shadow_step();
    {
      unsigned* ctr = cx.ctr + l * 2;
      int it = next_item(ctr, slot, wv);
      while (it < 32) {
        const int kv = it & 1, mt = it >> 1;
        ADCmp ad{cx.proj + (kv ? C_VCMP : C_KCMP), PS};
        EpiCmp1 ep{cx.hid + (size_t)kv * 4096 * 128, cx.c1 + (l * 2 + kv) * 128};
        gemm_tile<false>(ad, cx.w1 + (size_t)(l * 2 + kv) * 128 * 2048, 2048, mt * 256, 0, ep, lds, wv);
        it = next_item(ctr, slot, wv);
      }
      SCHED_BARRIER();
      while (it < 544) {
        const int r = it - 32;
        ADLin ad{cx.proj + C_CQ, PS, 64};
        EpiMlaQ ep{cx.qm, cx.rope};
        gemm_tile<true>(ad, cx.wuq + (size_t)l * 512 * 256, 256, (r >> 2) * 256, (r & 3) * 128, ep, lds, wv);
        it = next_item(ctr, slot, wv);
      }
      SCHED_BARRIER();
      while (it < 1184) {
        const int r = it - 544;
        ADLin ad{cx.proj + C_CKV, PS, 64};
        EpiMlaKV ep{cx.kn, cx.mlavT};
        gemm_tile<true>(ad, cx.wukv + (size_t)l * 640 * 128, 128, (r / 5) * 256, (r % 5) * 128, ep, lds, wv);
        it = next_item(ctr, slot, wv);
      }
    }
    gbar(barw, gen, wv);
    shadow_step();
    {
      unsigned* ctr = cx.ctr + l * 2 + 1;
      const float* gn = p.in[14] + (size_t)l * 320;
      unsigned* cflag = cx.ctr + 64 + l * 16;
      int it = next_item(ctr, slot, wv);
      while (it < 32) {
        const int kv = it & 1, mt = it >> 1;
        ADLin ad{cx.hid + (size_t)kv * 4096 * 128, 128, 64};
        EpiCmp2 ep{cx.kc, cx.vcT, kv};
        gemm_tile<false>(ad, cx.w2 + (size_t)(l * 2 + kv) * 128 * 128, 128, mt * 256, 0, ep, lds, wv);
        asm volatile("s_waitcnt vmcnt(0)" ::: "memory");
        __syncthreads();
        const int tb = opaque_tid(wv);
        if (tb < 64) {
          __builtin_amdgcn_fence(__ATOMIC_RELEASE, "agent");
          asm volatile("s_waitcnt vmcnt(0)" ::: "memory");
          if (tb == 0) __hip_atomic_fetch_add(cflag + mt, 1u, __ATOMIC_RELAXED, __HIP_MEMORY_SCOPE_AGENT);
        }
        it = next_item(ctr, slot, wv);
      }
      it -= 32;
      while (it < 80) { ret_item(cx, gn, xf, p.in[2] + (size_t)l * 1024, p.in[3] + (size_t)l * 1024 * 2866, it / 5, it % 5, lds, wv); it = next_item(ctr, slot, wv) - 32; }
#pragma unroll 1
      for (int grp = 0; grp < 8; ++grp) {
        const int base = 80 + grp * 144;
        while (it < base + 80) { const int r = it - base; mla_item(cx, r / 5, r % 5, 7 - grp, lds, wv); it = next_item(ctr, slot, wv) - 32; }
        SCHED_BARRIER();
        while (it < base + 144) { const int r = it - base - 80; const int e = r & 31; nsa_item(cx, cflag, e >> 1, e & 1, (r < 32 ? 15 : 14) - 2 * grp, lds, wv); it = next_item(ctr, slot, wv) - 32; }
      }
    }
    gbar(barw, gen, wv);
    shadow_step();
    {
      float* ssA = (float*)(ws + WS_SS);
      const int tid = opaque_tid(wv);
      EpiAdaptResid ep{xf, cx.xb, ssA, nullptr};
      pg8::Gemm g{cx.mixed, cx.wout + (size_t)l * 1024 * 1024, T, 1024, 1024};
      pg8::StaticOrder so; so.init(T, 1024, nblk, bid);
      __syncthreads();
      pg8::gemm_phase<EpiAdaptResid, pg8::StaticOrder, true, true>((PG8_LAS unsigned char*)lds, g, so, ep, tid);
      __syncthreads();
    }
    gbar(barw, gen, wv);
    shadow_step();
    {
      float* ssA = (float*)(ws + WS_SS);
      const int tid = opaque_tid(wv);
      EpiAdaptRelu2 ep{cx.u, ssA};
      pg8::Gemm g{cx.xb, cx.wup + (size_t)l * 4096 * 1024, T, 4096, 1024};
      pg8::StaticOrder so; so.init(T, 4096, nblk, bid);
      __syncthreads();
      pg8::gemm_phase<EpiAdaptRelu2, pg8::StaticOrder, true, true>((PG8_LAS unsigned char*)lds, g, so, ep, tid);
      __syncthreads();
    }
    gbar(barw, gen, wv);
    shadow_step();
    {
      float* ssB = (float*)(ws + WS_SS) + (size_t)T * 16;
      const int tid = opaque_tid(wv);
      EpiAdaptResid ep{xf, cx.xb, ssB, l == 0 ? SX : SNAP + (size_t)l * 16 * 1024};
      pg8::Gemm g{cx.u, cx.wdown + (size_t)l * 1024 * 4096, T, 1024, 4096};
      pg8::StaticOrder so; so.init(T, 1024, nblk, bid);
      __syncthreads();
      pg8::gemm_phase<EpiAdaptResid, pg8::StaticOrder, true, true>((PG8_LAS unsigned char*)lds, g, so, ep, tid);
      __syncthreads();
    }
    gbar(barw, gen, wv);
  }
  {
    const float* fg = p.in[19];
    const int tid = opaque_tid(wv), lane = tid & 63, wave = tid >> 6;
    for (int t = bid * 8 + wave; t < T; t += nblk * 8) {
      float* r = xf + (size_t)t * DM;
      const float* rin = ((t & 2047) == 0) ? (SX + (size_t)(t >> 11) * 1024) : r;
      float4 v[4]; float ss = 0.f;
#pragma unroll
      for (int j = 0; j < 4; ++j) { v[j] = *(const float4*)(rin + j * 256 + lane * 4); ss += v[j].x * v[j].x + v[j].y * v[j].y + v[j].z * v[j].z + v[j].w * v[j].w; }
      ss += shx32(ss, lane); ss += shx<16>(ss); ss += shx<8>(ss); ss += shx<4>(ss); ss += shx<2>(ss); ss += shx<1>(ss);
      const float sc = rsqrtf(ss * (1.f / 1024.f) + 1e-6f);
#pragma unroll
      for (int j = 0; j < 4; ++j) {
        const float4 g = *(const float4*)(fg + j * 256 + lane * 4);
        float4 w; w.x = v[j].x * sc * g.x; w.y = v[j].y * sc * g.y; w.z = v[j].z * sc * g.z; w.w = v[j].w * sc * g.w;
        *(float4*)(r + j * 256 + lane * 4) = w;
      }
    }
  }
}

extern "C" void kernel_launch(void* const* d_in, const int* in_sizes, int n_in, void* d_out, int out_size,
                              void* d_ws, size_t ws_size, hipStream_t stream) {
  static int grid_blocks = 0;
  if (!grid_blocks) {
    int dev = 0, cus = 0, per_cu = 0;
    (void)hipGetDevice(&dev);
    (void)hipDeviceGetAttribute(&cus, hipDeviceAttributeMultiprocessorCount, dev);
    (void)hipFuncSetAttribute((const void*)mega, hipFuncAttributeMaxDynamicSharedMemorySize, LDS_TOTAL);
    (void)hipOccupancyMaxActiveBlocksPerMultiprocessor(&per_cu, (const void*)mega, 512, LDS_TOTAL);
    if (per_cu < 1) { fprintf(stderr, "occupancy query returned %d\n", per_cu); per_cu = 1; }
    (void)hipGetLastError();
    grid_blocks = 256;
    if (cus < 256) fprintf(stderr, "device has %d CUs, kernel needs 256\n", cus);
  }
  (void)hipMemsetAsync((unsigned char*)d_ws + WS_CTR + 4096 * 4, 0, 256, stream);
  Params p{};
  for (int i = 0; i < 20; ++i) p.in[i] = (const float*)d_in[i];
  p.out = (float*)d_out; p.ws = (unsigned char*)d_ws;
  void* args[] = {&p};
  hipError_t e = hipLaunchCooperativeKernel((const void*)mega, dim3(grid_blocks), dim3(512), args, LDS_TOTAL, stream);
  if (e != hipSuccess) fprintf(stderr, "cooperative launch failed: %s (grid %d)\n", hipGetErrorString(e), grid_blocks);
}
```

```cpp
#include <hip/hip_runtime.h>
#include <hip/hip_cooperative_groups.h>
#include <cstdio>
#include <cstdint>
namespace cg = cooperative_groups;

typedef unsigned short bf16_t;
typedef short bf16x8 __attribute__((ext_vector_type(8)));
typedef float f32x4 __attribute__((ext_vector_type(4)));
typedef unsigned u32x4 __attribute__((ext_vector_type(4)));
typedef unsigned u32x2 __attribute__((ext_vector_type(2)));
#define DEVI __device__ __forceinline__

constexpr int T = 32768, S = 2048, DM = 1024, DFF = 4096;
constexpr int PS = 2304;
constexpr int NIN = 3072;
constexpr int C_Q = 0, C_KCMP = 384, C_VCMP = 512, C_KSLC = 640, C_KWIN = 768, C_GATE = 896, C_CQ = 928, C_CKV = 1184,
              C_KPE = 1312, C_RQ = 1344, C_RK = 1664, C_RG = 1984, C_VSLC = 2304, C_VWIN = 2432, C_RV = 2560, C_END = 2880;
constexpr float LOG2E = 1.4426950408889634f;
constexpr float QSCALE_NSA = 0.125f * LOG2E;
constexpr float QSCALE_MLA = 0.10206207261596575f * LOG2E;

constexpr size_t MiB = 1ull << 20;
constexpr size_t WS_U = 0, WS_PROJ = 0, WS_MIXED = 144 * MiB, WS_QM = 208 * MiB, WS_VSLCT = 240 * MiB, WS_VWINT = 248 * MiB;
constexpr size_t WS_XB = 256 * MiB, WS_KN = 320 * MiB, WS_RETVT = 340 * MiB, WS_MLAVT = 360 * MiB, WS_HID = 380 * MiB;
constexpr size_t WS_KC = 382 * MiB, WS_VCT = WS_KC + 512 * 1024, WS_ROPE = 383 * MiB;
constexpr size_t WS_WIN = 397 * MiB, WS_WOUT = 421 * MiB, WS_WUP = 429 * MiB, WS_WDOWN = 461 * MiB, WS_W1 = 493 * MiB;
constexpr size_t WS_W2 = 497 * MiB, WS_WUQ = 498 * MiB, WS_WUKV = 499 * MiB, WS_C1 = 500 * MiB, WS_CTR = WS_C1 + 65536, WS_SS = 502 * MiB;

constexpr int LDS_ROW = 144;
constexpr int LDS_A_BYTES = 256 * LDS_ROW, LDS_B_BYTES = 128 * LDS_ROW, LDS_STAGE = LDS_A_BYTES + LDS_B_BYTES;
constexpr int LDS_RS_OFF = 2 * LDS_STAGE;
constexpr int LDS_SLOT = 131072;
constexpr int LDS_TOTAL = LDS_SLOT + 64;
constexpr int KROW_MLA = 208;
constexpr int ATT_K0 = 0, ATT_KSZ = 64 * KROW_MLA, ATT_V0 = 2 * ATT_KSZ, ATT_VSZ = 64 * LDS_ROW;
constexpr int ATT_IMPA = ATT_V0 + 2 * ATT_VSZ, ATT_IMPB = ATT_IMPA + 128 * 33 * 4, ATT_SELM = ATT_IMPB + 128 * 33 * 4, ATT_BMASK = ATT_SELM + 512;
constexpr int RET_KS = 0, RET_KWT = 128 * LDS_ROW, RET_ROWT = 272, RET_VT = RET_KWT + 64 * RET_ROWT, RET_ST = RET_VT + 64 * RET_ROWT;

struct Params { const float* in[20]; float* out; unsigned char* ws; };

DEVI float bf2f(bf16_t b) { return __uint_as_float(((unsigned)b) << 16); }
DEVI unsigned pk2(float lo, float hi) { unsigned r; asm("v_cvt_pk_bf16_f32 %0, %1, %2" : "=v"(r) : "v"(lo), "v"(hi)); return r; }
DEVI bf16_t f2bf(float f) { return (bf16_t)(pk2(f, 0.f) & 0xffffu); }
DEVI f32x4 mfma16(bf16x8 a, bf16x8 b, f32x4 c) { return __builtin_amdgcn_mfma_f32_16x16x32_bf16(a, b, c, 0, 0, 0); }
DEVI float fexp2(float x) { return __builtin_amdgcn_exp2f(x); }
DEVI bf16x8 as_bf8(u32x4 u) { union { u32x4 u; bf16x8 b; } x; x.u = u; return x.b; }
DEVI void store_bf4(bf16_t* p, f32x4 v) { u32x2 w; w.x = pk2(v[0], v[1]); w.y = pk2(v[2], v[3]); *(u32x2*)p = w; }
DEVI float sigmoidf(float x) { return 1.f / (1.f + __expf(-x)); }

DEVI int opaque_tid(int wv) { int t; asm volatile("v_mbcnt_lo_u32_b32 %0, -1, 0\n\tv_mbcnt_hi_u32_b32 %0, -1, %0" : "=v"(t)); return wv * 64 + t; }
template <int M> DEVI float shx(float v) { return __int_as_float(__builtin_amdgcn_ds_swizzle(__float_as_int(v), (M << 10) | 0x1f)); }
template <int M> DEVI unsigned shxu(unsigned v) { return (unsigned)__builtin_amdgcn_ds_swizzle((int)v, (M << 10) | 0x1f); }
DEVI float shx32(float v, int lane) { return __int_as_float(__builtin_amdgcn_ds_bpermute((lane ^ 32) << 2, __float_as_int(v))); }
DEVI int permd(int d, int half) { return (d < 2 * half) ? ((d & 1) ? (d >> 1) + half : (d >> 1)) : d; }
DEVI int inproj_src_col(int n) {
  if (n < 384) return (n & ~63) + permd(n & 63, 8);
  if (n < 512) { int e = n - 384; return 384 + (e & ~63) + permd(e & 63, 8); }
  if (n < 640) return n;
  if (n < 768) { int e = n - 640; return 640 + (e & ~63) + permd(e & 63, 8); }
  if (n < 896) { int e = n - 768; return 896 + (e & ~63) + permd(e & 63, 8); }
  if (n < 928) { int e = n - 896; return e < 18 ? 1152 + e : -1; }
  if (n < 1184) return 1170 + (n - 928);
  if (n < 1312) return 1426 + (n - 1184);
  if (n < 1344) return 1554 + permd(n - 1312, 16);
  if (n < 1664) { int e = n - 1344; return 1586 + (e & ~63) + permd(e & 63, 32); }
  if (n < 1984) { int e = n - 1664; return 1906 + (e & ~63) + permd(e & 63, 32); }
  if (n < 2304) return 2546 + (n - 1984);
  if (n < 2432) return 768 + (n - 2304);
  if (n < 2560) return 1024 + (n - 2432);
  if (n < 2880) return 2226 + (n - 2560);
  return -1;
}
DEVI int map_col(int kind, int n) {
  switch (kind) {
    case 0: return inproj_src_col(n);
    case 6: return n < 64 ? permd(n, 8) : -1;
    case 7: return n < 64 ? n : -1;
    case 8: { if (n >= 480) return -1; int h = n / 96, d = n % 96; return h * 96 + (d < 64 ? d : 64 + permd(d - 64, 16)); }
    case 9: { if (n < 320) { return (n >> 6) * 128 + (n & 63); } int e = n - 320; return (e >> 6) * 128 + 64 + (e & 63); }
    default: return n;
  }
}
DEVI int map_row(int kind, int k) { return kind == 4 ? (k & ~63) + permd(k & 63, 8) : k; }

DEVI void transpose_tile(const float* __restrict__ src, int ldsrc, bf16_t* __restrict__ dst, int K, int k0, int n0,
                         const float* __restrict__ gain, int kind, float* lt, int wv) {
  const int tid = opaque_tid(wv);
  const int nn = tid & 127, kq = tid >> 7;
  const int sc = map_col(kind, n0 + nn);
  float v[16];
#pragma unroll
  for (int i = 0; i < 16; ++i) {
    const int kk = kq + i * 4;
    v[i] = 0.f;
    if (sc >= 0) { const int sr = map_row(kind, k0 + kk); v[i] = src[(size_t)sr * ldsrc + sc]; if (gain) v[i] *= gain[k0 + kk]; }
  }
#pragma unroll
  for (int i = 0; i < 16; ++i) lt[nn * 65 + kq + i * 4] = v[i];
  __syncthreads();
#pragma unroll
  for (int h = 0; h < 2; ++h) {
    const int kc = tid & 7, n2 = (tid >> 3) + h * 64;
    const float* p = lt + n2 * 65 + kc * 8;
    u32x4 w; w.x = pk2(p[0], p[1]); w.y = pk2(p[2], p[3]); w.z = pk2(p[4], p[5]); w.w = pk2(p[6], p[7]);
    *(u32x4*)(dst + (size_t)(n0 + n2) * K + k0 + kc * 8) = w;
  }
  __syncthreads();
}

struct ADLin { const bf16_t* base; int lda; int kstride; DEVI const bf16_t* rowptr(int m) const { return base + (size_t)m * lda; } };
struct ADCmp { const bf16_t* base; int kstride;
  DEVI const bf16_t* rowptr(int m) const { int b = m >> 8, n = (m >> 1) & 127, g = m & 1; if (n > 126) n = 126; return base + ((size_t)(b * S + n * 16)) * PS + g * 64; } };

template <bool ROWSS, class AD, class Epi>
DEVI void gemm_tile(const AD& ad, const bf16_t* __restrict__ Bt, int K, int m0, int n0, const Epi& epi, unsigned char* lds, int wv) {
  const int tid = opaque_tid(wv), lane = tid & 63, wave = tid >> 6;
  const int idx = lane & 15, quad = lane >> 4;
  const int wm = wave >> 1, wn = wave & 1;
  const int lc = tid & 7, lr = tid >> 3;
  const bf16_t* ap[4]; const bf16_t* bp[2];
#pragma unroll
  for (int i = 0; i < 4; ++i) ap[i] = ad.rowptr(m0 + lr + 64 * i) + lc * 8;
#pragma unroll
  for (int i = 0; i < 2; ++i) bp[i] = Bt + (size_t)(n0 + lr + 64 * i) * K + lc * 8;
  const int aks = ad.kstride;
  u32x4 ra[4], rb[2];
  float ss[4] = {0.f, 0.f, 0.f, 0.f};
  f32x4 acc[4][4];
#pragma unroll
  for (int i = 0; i < 4; ++i)
#pragma unroll
    for (int j = 0; j < 4; ++j) acc[i][j] = (f32x4){0.f, 0.f, 0.f, 0.f};
  const int nk = K >> 6;
#pragma unroll
  for (int i = 0; i < 4; ++i) ra[i] = *(const u32x4*)(ap[i]);
#pragma unroll
  for (int i = 0; i < 2; ++i) rb[i] = *(const u32x4*)(bp[i]);
  auto stage_write = [&](int s) {
    unsigned char* A = lds + s * LDS_STAGE; unsigned char* B = A + LDS_A_BYTES;
#pragma unroll
    for (int i = 0; i < 4; ++i) *(u32x4*)(A + (lr + 64 * i) * LDS_ROW + lc * 16) = ra[i];
#pragma unroll
    for (int i = 0; i < 2; ++i) *(u32x4*)(B + (lr + 64 * i) * LDS_ROW + lc * 16) = rb[i];
    if (ROWSS) {
#pragma unroll
      for (int i = 0; i < 4; ++i)
#pragma unroll
        for (int e = 0; e < 4; ++e) { unsigned w = ra[i][e]; float lo = __uint_as_float(w << 16), hi = __uint_as_float(w & 0xffff0000u); ss[i] += lo * lo + hi * hi; }
    }
  };
  stage_write(0);
  __syncthreads();
#pragma unroll 1
  for (int kk = 0; kk < nk; ++kk) {
    if (kk + 1 < nk) {
#pragma unroll
      for (int i = 0; i < 4; ++i) ra[i] = *(const u32x4*)(ap[i] + (size_t)(kk + 1) * aks);
#pragma unroll
      for (int i = 0; i < 2; ++i) rb[i] = *(const u32x4*)(bp[i] + (kk + 1) * 64);
    }
    const unsigned char* A = lds + (kk & 1) * LDS_STAGE + (wm * 64 + idx) * LDS_ROW + quad * 16;
    const unsigned char* B = lds + (kk & 1) * LDS_STAGE + LDS_A_BYTES + (wn * 64 + idx) * LDS_ROW + quad * 16;
#pragma unroll
    for (int ks = 0; ks < 2; ++ks) {
      bf16x8 af[4], wf[4];
#pragma unroll
      for (int i = 0; i < 4; ++i) af[i] = *(const bf16x8*)(A + i * 16 * LDS_ROW + ks * 64);
#pragma unroll
      for (int j = 0; j < 4; ++j) wf[j] = *(const bf16x8*)(B + j * 16 * LDS_ROW + ks * 64);
#pragma unroll
      for (int i = 0; i < 4; ++i)
#pragma unroll
        for (int j = 0; j < 4; ++j) acc[i][j] = mfma16(wf[j], af[i], acc[i][j]);
    }
    if (kk + 1 < nk) stage_write((kk + 1) & 1);
    __syncthreads();
  }
  float rs[4] = {1.f, 1.f, 1.f, 1.f};
  if (ROWSS) {
    float* rsl = (float*)(lds + LDS_RS_OFF);
#pragma unroll
    for (int i = 0; i < 4; ++i) {
      float v = ss[i]; v += shx<1>(v); v += shx<2>(v); v += shx<4>(v);
      if (lc == 0) rsl[lr + 64 * i] = rsqrtf(v / (float)K + 1e-6f);
    }
    __syncthreads();
#pragma unroll
    for (int i = 0; i < 4; ++i) rs[i] = rsl[wm * 64 + i * 16 + idx];
  }
#pragma unroll
  for (int j = 0; j < 4; ++j) {
    const int n = n0 + wn * 64 + j * 16 + quad * 4;
#pragma unroll
    for (int i = 0; i < 4; ++i) epi(m0 + wm * 64 + i * 16 + idx, n, acc[i][j], rs[i]);
  }
}

struct EpiInProj {
  bf16_t* proj; bf16_t* vslcT; bf16_t* vwinT; bf16_t* retvT; const float* rope;
  DEVI void operator()(int m, int n, f32x4 v, float rs) const {
    if (n >= C_END) return;
    v *= rs;
    if (n < C_VSLC) {
      int ri = -1; float sc = 1.f;
      if (n < C_VCMP) { int d = n & 63; if (d < 16) ri = d >> 1; if (n < C_KCMP) sc = QSCALE_NSA; }
      else if (n < C_KSLC) {}
      else if (n < C_GATE) { int d = n & 63; if (d < 16) ri = d >> 1; }
      else if (n < C_KPE) {}
      else if (n < C_RQ) { ri = 8 + ((n - C_KPE) >> 1); }
      else if (n < C_RG) { int d = (n - C_RQ) & 63; ri = 24 + (d >> 1); if (n >= C_RK) sc = 0.125f; }
      if (ri >= 0) {
        const float4 cs = *(const float4*)(rope + ((size_t)m * 56 + ri) * 2);
        float a0 = v[0] * cs.x - v[1] * cs.y, a1 = v[1] * cs.x + v[0] * cs.y;
        float a2 = v[2] * cs.z - v[3] * cs.w, a3 = v[3] * cs.z + v[2] * cs.w;
        v = (f32x4){a0, a1, a2, a3};
      }
      v *= sc;
      store_bf4(proj + (size_t)m * PS + n, v);
    } else {
      const int b = m >> 11, s = m & 2047;
      bf16_t* dst;
      if (n < C_VWIN) { int e = n - C_VSLC; dst = vslcT + ((size_t)((b * 2 + (e >> 6)) * 64 + (e & 63))) * S + s; }
      else if (n < C_RV) { int e = n - C_VWIN; dst = vwinT + ((size_t)((b * 2 + (e >> 6)) * 64 + (e & 63))) * S + s; }
      else { int e = n - C_RV; dst = retvT + ((size_t)((b * 5 + (e >> 6)) * 64 + (e & 63))) * S + s; }
#pragma unroll
      for (int j = 0; j < 4; ++j) dst[(size_t)j * S] = f2bf(v[j]);
    }
  }
};
struct EpiMlaQ {
  bf16_t* qm; const float* rope;
  DEVI void operator()(int m, int n, f32x4 v, float rs) const {
    if (n >= 480) return;
    v *= rs;
    int d = n % 96;
    if (d >= 64) {
      const float4 cs = *(const float4*)(rope + ((size_t)m * 56 + 8 + ((d - 64) >> 1)) * 2);
      float a0 = v[0] * cs.x - v[1] * cs.y, a1 = v[1] * cs.x + v[0] * cs.y;
      float a2 = v[2] * cs.z - v[3] * cs.w, a3 = v[3] * cs.z + v[2] * cs.w;
      v = (f32x4){a0, a1, a2, a3};
    }
    v *= QSCALE_MLA;
    store_bf4(qm + (size_t)m * 512 + n, v);
  }
};
struct EpiMlaKV {
  bf16_t* kn; bf16_t* mlavT;
  DEVI void operator()(int m, int n, f32x4 v, float rs) const {
    v *= rs;
    if (n < 320) { store_bf4(kn + (size_t)m * 320 + n, v); }
    else {
      const int b = m >> 11, s = m & 2047; int e = n - 320;
      bf16_t* dst = mlavT + ((size_t)((b * 5 + (e >> 6)) * 64 + (e & 63))) * S + s;
#pragma unroll
      for (int j = 0; j < 4; ++j) dst[(size_t)j * S] = f2bf(v[j]);
    }
  }
};
struct EpiCmp1 {
  bf16_t* hid; const float* c1;
  DEVI void operator()(int m, int n, f32x4 v, float) const {
    const float4 bb = *(const float4*)(c1 + n);
    float x[4] = {v[0] + bb.x, v[1] + bb.y, v[2] + bb.z, v[3] + bb.w};
    f32x4 o;
#pragma unroll
    for (int j = 0; j < 4; ++j) {
      float y = 0.7978845608028654f * (x[j] + 0.044715f * x[j] * x[j] * x[j]);
      float th = 1.f - 2.f / (__expf(2.f * y) + 1.f);
      o[j] = 0.5f * x[j] * (1.f + th);
    }
    store_bf4(hid + (size_t)m * 128 + n, o);
  }
};
struct EpiCmp2 {
  bf16_t* kc; bf16_t* vcT; int kv;
  DEVI void operator()(int m, int n, f32x4 v, float) const {
    if (n >= 64) return;
    if (kv == 0) { store_bf4(kc + (size_t)m * 64 + n, v); }
    else {
      int b = m >> 8, nc = (m >> 1) & 127, g = m & 1;
      bf16_t* dst = vcT + ((size_t)((b * 2 + g) * 64 + n)) * 128 + nc;
#pragma unroll
      for (int j = 0; j < 4; ++j) dst[j * 128] = f2bf(v[j]);
    }
  }
};
struct EpiResid {
  float* xf; bf16_t* xb;
  DEVI void operator()(int m, int n, f32x4 v, float) const {
    float* p = xf + (size_t)m * DM + n;
    f32x4 x = *(const f32x4*)p;
    x += v;
    *(f32x4*)p = x;
    store_bf4(xb + (size_t)m * DM + n, x);
  }
};
struct EpiRelu2 {
  bf16_t* u;
  DEVI void operator()(int m, int n, f32x4 v, float rs) const {
    f32x4 o;
#pragma unroll
    for (int j = 0; j < 4; ++j) { float h = fmaxf(v[j] * rs, 0.f); o[j] = h * h; }
    store_bf4(u + (size_t)m * DFF + n, o);
  }
};

#define SCHED_BARRIER() __builtin_amdgcn_sched_barrier(0)
template <int NC, int KS>
DEVI void qk_half(const unsigned char* Kl, int krow, const bf16x8 (&q)[NC][KS], f32x4 (&s)[NC][2], int idx, int quad) {
#pragma unroll
  for (int u = 0; u < 2; ++u) {
#pragma unroll
    for (int c = 0; c < NC; ++c) s[c][u] = (f32x4){0.f, 0.f, 0.f, 0.f};
#pragma unroll
    for (int ks = 0; ks < KS; ++ks) {
      bf16x8 kf = *(const bf16x8*)(Kl + (u * 16 + idx) * krow + ks * 64 + quad * 16);
#pragma unroll
      for (int c = 0; c < NC; ++c) s[c][u] = mfma16(kf, q[c][ks], s[c][u]);
    }
  }
}
template <int NC>
DEVI void pv_half(const unsigned char* Vl, int vrow, const bf16x8 (&pb)[NC], f32x4 (&o)[NC][4], int idx, int quad) {
#pragma unroll
  for (int dvt = 0; dvt < 4; ++dvt) {
    const unsigned char* p = Vl + (dvt * 16 + idx) * vrow + quad * 8;
    u32x2 lo = *(const u32x2*)p, hi = *(const u32x2*)(p + 32);
    bf16x8 vf = as_bf8((u32x4){lo.x, lo.y, hi.x, hi.y});
#pragma unroll
    for (int c = 0; c < NC; ++c) o[c][dvt] = mfma16(vf, pb[c], o[c][dvt]);
  }
}
DEVI bf16x8 pack_p(const f32x4& a, const f32x4& b) { return as_bf8((u32x4){pk2(a[0], a[1]), pk2(a[2], a[3]), pk2(b[0], b[1]), pk2(b[2], b[3])}); }
template <int NC, int KS, class MaskF>
DEVI void attn_tile(const unsigned char* Kl, int krow, const unsigned char* Vl, const bf16x8 (&q)[NC][KS], f32x4 (&o)[NC][4],
                    float (&mr)[NC], float (&lr)[NC], int idx, int quad, int mask_mode, bool lane_ok, const MaskF& mf) {
#pragma unroll
  for (int hf = 0; hf < 2; ++hf) {
    f32x4 s[NC][2];
    qk_half<NC, KS>(Kl + hf * 32 * krow, krow, q, s, idx, quad);
    bf16x8 pb[NC];
#pragma unroll
    for (int c = 0; c < NC; ++c) {
      if (mask_mode == 2) {
#pragma unroll
        for (int u = 0; u < 2; ++u)
#pragma unroll
          for (int j = 0; j < 4; ++j) s[c][u][j] = mf(c, hf * 32 + u * 16 + quad * 4 + j) ? s[c][u][j] : -1e30f;
      } else if (mask_mode == 1) {
#pragma unroll
        for (int u = 0; u < 2; ++u)
#pragma unroll
          for (int j = 0; j < 4; ++j) s[c][u][j] = lane_ok ? s[c][u][j] : -1e30f;
      }
      float ps = 0.f;
      f32x4 p0, p1;
#pragma unroll
      for (int j = 0; j < 4; ++j) { p0[j] = fexp2(s[c][0][j] - mr[c]); p1[j] = fexp2(s[c][1][j] - mr[c]); ps += p0[j] + p1[j]; }
      if (__builtin_amdgcn_ballot_w64(!(ps <= 2048.f)) != 0ull) {
        float mx = fmaxf(fmaxf(fmaxf(s[c][0][0], s[c][0][1]), fmaxf(s[c][0][2], s[c][0][3])), fmaxf(fmaxf(s[c][1][0], s[c][1][1]), fmaxf(s[c][1][2], s[c][1][3])));
        mx = fmaxf(mx, shx<16>(mx)); mx = fmaxf(mx, shx32(mx, quad * 16 + idx));
        const float mnew = fmaxf(mr[c], mx);
        const float alpha = fexp2(mr[c] - mnew);
        lr[c] *= alpha; mr[c] = mnew;
#pragma unroll
        for (int dvt = 0; dvt < 4; ++dvt) o[c][dvt] *= alpha;
        ps = 0.f;
#pragma unroll
        for (int j = 0; j < 4; ++j) { p0[j] = fexp2(s[c][0][j] - mnew); p1[j] = fexp2(s[c][1][j] - mnew); ps += p0[j] + p1[j]; }
      }
      lr[c] += ps;
      s[c][0] = p0; s[c][1] = p1;
      pb[c] = pack_p(s[c][0], s[c][1]);
    }
    pv_half<NC>(Vl + hf * 64, LDS_ROW, pb, o, idx, quad);
    if (NC > 2) SCHED_BARRIER();
  }
}

struct Ctx {
  bf16_t *proj, *mixed, *qm, *vslcT, *vwinT, *xb, *kn, *retvT, *mlavT, *hid, *kc, *vcT, *u;
  float* rope; float* c1; unsigned* ctr;
  bf16_t *win, *wout, *wup, *wdown, *w1, *w2, *wuq, *wukv;
};

DEVI void nsa_item(const Ctx& cx, const unsigned* cflag, int b, int g, int qt, unsigned char* lds, int wv) {
  {
    const int lane0 = opaque_tid(wv);
  if (lane0 < 64) {
    if (lane0 == 0) { while (__hip_atomic_load(cflag + b, __ATOMIC_RELAXED, __HIP_MEMORY_SCOPE_AGENT) < 2u) __builtin_amdgcn_s_sleep(2); }
    __builtin_amdgcn_fence(__ATOMIC_ACQUIRE, "agent");
    asm volatile("s_waitcnt vmcnt(0)" ::: "memory");
  }
  __syncthreads();
  }
  const int tid = opaque_tid(wv), lane = tid & 63, wave = tid >> 6, idx = lane & 15, quad = lane >> 4;
  const int t0 = qt * 128;
  const int tq = t0 + wave * 16 + idx;
  const unsigned tokrow = (unsigned)(b * S + tq);
  const bf16_t* proj = cx.proj;
  const int lc = tid & 7, lr = tid >> 3;
  f32x4* const scrb = (f32x4*)cx.xb; const unsigned scro = ((unsigned)(blockIdx.x * 8 + wave) * 64u + (unsigned)lane) * 12u;
#define scr (scrb + scro)
  bf16x8 q[3][2];
#pragma unroll
  for (int c = 0; c < 3; ++c)
#pragma unroll
    for (int ks = 0; ks < 2; ++ks) q[c][ks] = *(const bf16x8*)(proj + (size_t)tokrow * PS + C_Q + (g * 3 + c) * 64 + ks * 32 + quad * 8);
  f32x4 o[3][4];
  float mr[3], lrn[3];
#pragma unroll
  for (int c = 0; c < 3; ++c) {
    mr[c] = -1e30f; lrn[c] = 0.f;
#pragma unroll
    for (int d = 0; d < 4; ++d) o[c][d] = (f32x4){0.f, 0.f, 0.f, 0.f};
  }
  float* impA = (float*)(lds + ATT_IMPA); float* impB = (float*)(lds + ATT_IMPB);
  unsigned* selm = (unsigned*)(lds + ATT_SELM); unsigned* bmaskp = (unsigned*)(lds + ATT_BMASK);
#pragma unroll
  for (int kt64 = 0; kt64 < 2; ++kt64) {
    u32x4 kr = *(const u32x4*)(cx.kc + ((size_t)((b * 128 + kt64 * 64 + lr) * 2 + g)) * 64 + lc * 8);
    u32x4 vr = *(const u32x4*)(cx.vcT + ((size_t)((b * 2 + g) * 64 + lr)) * 128 + kt64 * 64 + lc * 8);
    *(u32x4*)(lds + ATT_K0 + kt64 * ATT_KSZ + lr * LDS_ROW + lc * 16) = kr;
    *(u32x4*)(lds + ATT_V0 + kt64 * ATT_VSZ + lr * LDS_ROW + lc * 16) = vr;
  }
  if (tid == 0) *bmaskp = 0u;
  __syncthreads();
  const int wave_tmax = t0 + wave * 16 + 15, wave_tmin = t0 + wave * 16;
  const int nval = tq >= 31 ? ((tq - 31) >> 4) + 1 : 0;
  const int nval_w = wave_tmax >= 31 ? ((wave_tmax - 31) >> 4) + 1 : 0;
#pragma unroll 1
  for (int h32 = 0; h32 < 4; ++h32) {
    if (h32 * 32 < nval_w) {
      f32x4 s[3][2];
      qk_half<3, 2>(lds + ATT_K0 + (h32 >> 1) * ATT_KSZ + (h32 & 1) * 32 * LDS_ROW, LDS_ROW, q, s, idx, quad);
#pragma unroll
      for (int c = 0; c < 3; ++c) {
        float mx = -1e30f;
#pragma unroll
        for (int u = 0; u < 2; ++u)
#pragma unroll
          for (int j = 0; j < 4; ++j) { int n = h32 * 32 + u * 16 + quad * 4 + j; float v = (n < nval) ? s[c][u][j] : -1e30f; s[c][u][j] = v; mx = fmaxf(mx, v); }
        mx = fmaxf(mx, shx<16>(mx)); mx = fmaxf(mx, shx32(mx, quad * 16 + idx));
        const float mnew = fmaxf(mr[c], mx);
        float ps = 0.f;
#pragma unroll
        for (int u = 0; u < 2; ++u)
#pragma unroll
          for (int j = 0; j < 4; ++j) { float v = s[c][u][j]; ps += (v > -1e29f) ? fexp2(v - mnew) : 0.f; }
        ps += shx<16>(ps); ps += shx32(ps, quad * 16 + idx);
        lrn[c] = lrn[c] * fexp2(mr[c] - mnew) + ps; mr[c] = mnew;
      }
    }
  }
  float invl[3];
#pragma unroll
  for (int c = 0; c < 3; ++c) invl[c] = lrn[c] > 0.f ? 1.f / lrn[c] : 0.f;
  const int tl = wave * 16 + idx;
#pragma unroll 1
  for (int h32 = 0; h32 < 4; ++h32) {
    if (h32 * 32 < nval_w) {
      f32x4 s[3][2];
      qk_half<3, 2>(lds + ATT_K0 + (h32 >> 1) * ATT_KSZ + (h32 & 1) * 32 * LDS_ROW, LDS_ROW, q, s, idx, quad);
      bf16x8 pb[3];
#pragma unroll
      for (int c = 0; c < 3; ++c) {
#pragma unroll
        for (int u = 0; u < 2; ++u)
#pragma unroll
          for (int j = 0; j < 4; ++j) { int n = h32 * 32 + u * 16 + quad * 4 + j; s[c][u][j] = (n < nval) ? fexp2(s[c][u][j] - mr[c]) * invl[c] : 0.f; }
        pb[c] = pack_p(s[c][0], s[c][1]);
      }
      pv_half<3>(lds + ATT_V0 + (h32 >> 1) * ATT_VSZ + (h32 & 1) * 64, LDS_ROW, pb, o, idx, quad);
#pragma unroll
      for (int u = 0; u < 2; ++u) {
        float p0 = s[0][u][0] + s[1][u][0] + s[2][u][0], p1 = s[0][u][1] + s[1][u][1] + s[2][u][1];
        float p2 = s[0][u][2] + s[1][u][2] + s[2][u][2], p3 = s[0][u][3] + s[1][u][3] + s[2][u][3];
        const int mi = (h32 * 2 + u) * 4 + quad;
        impA[tl * 33 + mi] = p0 + p1 + p2 + 0.5f * p3;
        impB[tl * 33 + mi] = 0.5f * p3;
      }
    } else {
#pragma unroll
      for (int u = 0; u < 2; ++u) { const int mi = (h32 * 2 + u) * 4 + quad; impA[tl * 33 + mi] = 0.f; impB[tl * 33 + mi] = 0.f; }
    }
  }
  {
    const bf16_t* gp = proj + (size_t)(tokrow * (unsigned)PS + (unsigned)(C_GATE + g * 9));
#pragma unroll
    for (int c = 0; c < 3; ++c) {
      const float gt = sigmoidf(bf2f(gp[c * 3 + 0]));
#pragma unroll
      for (int d = 0; d < 4; ++d) { scr[c * 4 + d] = o[c][d] * gt; o[c][d] = (f32x4){0.f, 0.f, 0.f, 0.f}; }
      mr[c] = -1e29f; lrn[c] = 0.f;
    }
  }
  __syncthreads();
  {
    const int tl2 = tid >> 2, sub = tid & 3;
    const int cur = (t0 + tl2) >> 6;
    float a[32];
#pragma unroll
    for (int j = 0; j < 32; ++j) {
      float raw = impA[tl2 * 33 + j] + (j > 0 ? impB[tl2 * 33 + j - 1] : 0.f);
      bool valid = j <= cur, forced = (j == 0) | (j == cur) | (j == cur - 1);
      a[j] = valid ? (forced ? 1e9f : raw) : -1e30f;
    }
    unsigned bits = 0u;
#pragma unroll
    for (int e = 0; e < 8; ++e) {
      const int m = sub * 8 + e;
      float raw = impA[tl2 * 33 + m] + (m > 0 ? impB[tl2 * 33 + m - 1] : 0.f);
      bool valid = m <= cur, forced = (m == 0) | (m == cur) | (m == cur - 1);
      const float am = valid ? (forced ? 1e9f : raw) : -1e30f;
      int rank = 0;
#pragma unroll
      for (int j = 0; j < 32; ++j) rank += (a[j] > am || (a[j] == am && j < m)) ? 1 : 0;
      if (rank < 16 && valid) bits |= 1u << m;
    }
    bits |= shxu<1>(bits); bits |= shxu<2>(bits);
    if (sub == 0) { selm[tl2] = bits; atomicOr(bmaskp, bits); }
  }
  __syncthreads();
#pragma unroll
  for (int c = 0; c < 3; ++c)
#pragma unroll
    for (int ks = 0; ks < 2; ++ks) q[c][ks] = *(const bf16x8*)(proj + (size_t)tokrow * PS + C_Q + (g * 3 + c) * 64 + ks * 32 + quad * 8);
  const unsigned msel = selm[wave * 16 + idx];
  const unsigned bmask = *bmaskp;
  unsigned wmask = msel;
  wmask |= shxu<1>(wmask); wmask |= shxu<2>(wmask); wmask |= shxu<4>(wmask); wmask |= shxu<8>(wmask);
  unsigned wand = msel;
  wand &= shxu<1>(wand); wand &= shxu<2>(wand); wand &= shxu<4>(wand); wand &= shxu<8>(wand);
  const int mhi = 2 * qt + 1, wlo = (2 * qt - 8) > 0 ? (2 * qt - 8) : 0;
  unsigned long long winbits = ((mhi >= 31) ? 0xffffffffull : ((1ull << (mhi + 1)) - 1ull)) & ~((1ull << wlo) - 1ull);
  unsigned long long todo = (unsigned long long)bmask | (winbits << 32);
  bool in_win = false;
  u32x4 kr, vr;
  auto gload = [&](int e) {
    const int m = e & 31;
    const bf16_t* kp = proj + ((size_t)(b * S + m * 64 + lr)) * PS + (e < 32 ? C_KSLC : C_KWIN) + g * 64 + lc * 8;
    const bf16_t* vp = (e < 32 ? cx.vslcT : cx.vwinT) + ((size_t)((b * 2 + g) * 64 + lr)) * S + m * 64 + lc * 8;
    kr = *(const u32x4*)kp; vr = *(const u32x4*)vp;
  };
  auto lwrite = [&](int bi) {
    *(u32x4*)(lds + ATT_K0 + bi * ATT_KSZ + lr * LDS_ROW + lc * 16) = kr;
    *(u32x4*)(lds + ATT_V0 + bi * ATT_VSZ + lr * LDS_ROW + lc * 16) = vr;
  };
  int bi = 0;
  gload(__ffsll((long long)todo) - 1);
  lwrite(0);
  __syncthreads();
#pragma unroll 1
  while (todo) {
    const int e = __ffsll((long long)todo) - 1;
    todo &= todo - 1;
    const int en = todo ? (__ffsll((long long)todo) - 1) : -1;
    if (en >= 0) gload(en);
    const int m = e & 31;
    const bool is_win = e >= 32;
    if (is_win && !in_win) {
      in_win = true;
      const bf16_t* gp = proj + (size_t)(tokrow * (unsigned)PS + (unsigned)(C_GATE + g * 9));
#pragma unroll
      for (int c = 0; c < 3; ++c) {
        float lt = lrn[c]; lt += shx<16>(lt); lt += shx32(lt, quad * 16 + idx);
        const float gt = sigmoidf(bf2f(gp[c * 3 + 1])) * (lt > 0.f ? 1.f / lt : 0.f);
#pragma unroll
        for (int d = 0; d < 4; ++d) { scr[c * 4 + d] += o[c][d] * gt; o[c][d] = (f32x4){0.f, 0.f, 0.f, 0.f}; }
        mr[c] = -1e29f; lrn[c] = 0.f;
      }
    }
    const int kbase = m * 64;
    const bool active = is_win ? (kbase <= wave_tmax && kbase + 63 > wave_tmin - 512) : (((wmask >> m) & 1u) != 0u);
    if (active) {
      const int lo = is_win ? tq - 512 : -1;
      const bool selb = is_win ? true : (((msel >> m) & 1u) != 0u);
      const int mode = is_win ? (((kbase + 63 > wave_tmin) || (kbase <= wave_tmax - 512)) ? 2 : 0)
                              : ((kbase + 63 > wave_tmin) ? 2 : (((wand >> m) & 1u) ? 0 : 1));
      attn_tile<3, 2>(lds + ATT_K0 + bi * ATT_KSZ, LDS_ROW, lds + ATT_V0 + bi * ATT_VSZ, q, o, mr, lrn, idx, quad, mode, selb,
                      [&](int, int key) { const int kp = kbase + key; return selb && (kp <= tq) && (kp > lo); });
    }
    if (en >= 0) lwrite(bi ^ 1);
    __syncthreads();
    bi ^= 1;
  }
  {
    const bf16_t* gp = proj + (size_t)(tokrow * (unsigned)PS + (unsigned)(C_GATE + g * 9));
#pragma unroll
    for (int c = 0; c < 3; ++c) {
      float lt = lrn[c]; lt += shx<16>(lt); lt += shx32(lt, quad * 16 + idx);
      const float gt = sigmoidf(bf2f(gp[c * 3 + 2])) * (lt > 0.f ? 1.f / lt : 0.f);
#pragma unroll
      for (int d = 0; d < 4; ++d) store_bf4(cx.mixed + (size_t)(tokrow * (unsigned)DM + (unsigned)((g * 3 + c) * 64 + d * 16 + quad * 4)), scr[c * 4 + d] + o[c][d] * gt);
    }
  }
}

#undef scr
DEVI void mla_item(const Ctx& cx, int b, int h, int qt, unsigned char* lds, int wv) {
  const int tid = opaque_tid(wv), lane = tid & 63, wave = tid >> 6, idx = lane & 15, quad = lane >> 4;
  const int t0 = qt * 256;
  const int lc = tid & 7, lr = tid >> 3;
  const int lc2 = tid & 3, lr2 = (tid >> 2) & 63;
  int tq[2];
  bf16x8 q[2][3];
  f32x4 o[2][4]; float mr[2], lrn[2];
#pragma unroll
  for (int c = 0; c < 2; ++c) {
    tq[c] = t0 + wave * 32 + c * 16 + idx;
#pragma unroll
    for (int ks = 0; ks < 3; ++ks) q[c][ks] = *(const bf16x8*)(cx.qm + ((size_t)(b * S + tq[c])) * 512 + h * 96 + ks * 32 + quad * 8);
    mr[c] = -1e29f; lrn[c] = 0.f;
#pragma unroll
    for (int d = 0; d < 4; ++d) o[c][d] = (f32x4){0.f, 0.f, 0.f, 0.f};
  }
  const int wave_tmax = t0 + wave * 32 + 31;
  const int ntiles = 4 * qt + 4;
  u32x4 kr, vr, pr;
  auto gload = [&](int m) {
    kr = *(const u32x4*)(cx.kn + ((size_t)(b * S + m * 64 + lr)) * 320 + h * 64 + lc * 8);
    vr = *(const u32x4*)(cx.mlavT + ((size_t)((b * 5 + h) * 64 + lr)) * S + m * 64 + lc * 8);
    if (tid < 256) pr = *(const u32x4*)(cx.proj + ((size_t)(b * S + m * 64 + lr2)) * PS + C_KPE + lc2 * 8);
  };
  auto lwrite = [&](int bi) {
    *(u32x4*)(lds + ATT_K0 + bi * ATT_KSZ + lr * KROW_MLA + lc * 16) = kr;
    *(u32x4*)(lds + ATT_V0 + bi * ATT_VSZ + lr * LDS_ROW + lc * 16) = vr;
    if (tid < 256) *(u32x4*)(lds + ATT_K0 + bi * ATT_KSZ + lr2 * KROW_MLA + 128 + lc2 * 16) = pr;
  };
  gload(0); lwrite(0);
  __syncthreads();
  int bi = 0;
#pragma unroll 1
  for (int m = 0; m < ntiles; ++m) {
    if (m + 1 < ntiles) gload(m + 1);
    const int kbase = m * 64;
    if (kbase <= wave_tmax) {
      attn_tile<2, 3>(lds + ATT_K0 + bi * ATT_KSZ, KROW_MLA, lds + ATT_V0 + bi * ATT_VSZ, q, o, mr, lrn, idx, quad, (kbase + 63 > t0 + wave * 32) ? 2 : 0, true,
                      [&](int c, int key) { return kbase + key <= tq[c]; });
    }
    if (m + 1 < ntiles) lwrite(bi ^ 1);
    __syncthreads();
    bi ^= 1;
  }
#pragma unroll
  for (int c = 0; c < 2; ++c) {
    float lt = lrn[c]; lt += shx<16>(lt); lt += shx32(lt, quad * 16 + idx);
    const float il = lt > 0.f ? 1.f / lt : 0.f;
#pragma unroll
    for (int d = 0; d < 4; ++d) store_bf4(cx.mixed + ((size_t)(b * S + tq[c])) * DM + 384 + h * 64 + d * 16 + quad * 4, o[c][d] * il);
  }
}

DEVI void ret_item(const Ctx& cx, const float* __restrict__ gn, const float* __restrict__ xfl, const float* __restrict__ g1, const float* __restrict__ winl, int b, int h, unsigned char* lds, int wv) {
  const int tid = opaque_tid(wv), lane = tid & 63, wave = tid >> 6, idx = lane & 15, quad = lane >> 4;
  const float lg = log2f(1.f - exp2f(-5.f - (float)h));
  const int lc = tid & 7, lr = tid >> 3;
  const int vc = tid & 15, vrw = tid >> 4;
  f32x4 st[2];
  st[0] = (f32x4){0.f, 0.f, 0.f, 0.f}; st[1] = (f32x4){0.f, 0.f, 0.f, 0.f};
  const int et = wave >> 1, dt0 = (wave & 1) * 2;
  const float cdecay = fexp2(128.f * lg);
  const int i = wave * 16 + idx;
#pragma unroll 1
  for (int ci = 0; ci < 16; ++ci) {
    const int s0 = ci * 128;
    u32x4 kr[2], vr[2];
#pragma unroll
    for (int r = 0; r < 2; ++r) {
      kr[r] = *(const u32x4*)(cx.proj + ((size_t)(b * S + s0 + lr + 64 * r)) * PS + C_RK + h * 64 + lc * 8);
      vr[r] = *(const u32x4*)(cx.retvT + ((size_t)((b * 5 + h) * 64 + vrw + 32 * r)) * S + s0 + vc * 8);
    }
    const size_t tokrow = (size_t)(b * S + s0 + i);
    bf16x8 q[2];
#pragma unroll
    for (int ks = 0; ks < 2; ++ks) q[ks] = *(const bf16x8*)(cx.proj + tokrow * PS + C_RQ + h * 64 + ks * 32 + quad * 8);
    __syncthreads();
#pragma unroll
    for (int t = 0; t < 2; ++t)
#pragma unroll
      for (int j = 0; j < 4; ++j)
        *(bf16_t*)(lds + RET_ST + (et * 16 + quad * 4 + j) * LDS_ROW + ((dt0 + t) * 16 + idx) * 2) = f2bf(st[t][j]);
#pragma unroll
    for (int r = 0; r < 2; ++r) {
      const int row = lr + 64 * r;
      *(u32x4*)(lds + RET_KS + row * LDS_ROW + lc * 16) = kr[r];
      const float wd = fexp2((float)(127 - row) * lg);
#pragma unroll
      for (int e = 0; e < 4; ++e) {
        unsigned w = kr[r][e];
        float lo = __uint_as_float(w << 16) * wd, hi = __uint_as_float(w & 0xffff0000u) * wd;
        *(bf16_t*)(lds + RET_KWT + (lc * 8 + 2 * e) * RET_ROWT + row * 2) = f2bf(lo);
        *(bf16_t*)(lds + RET_KWT + (lc * 8 + 2 * e + 1) * RET_ROWT + row * 2) = f2bf(hi);
      }
      *(u32x4*)(lds + RET_VT + (vrw + 32 * r) * RET_ROWT + vc * 16) = vr[r];
    }
    __syncthreads();
    bf16x8 pb[4];
#pragma unroll
    for (int kc = 0; kc < 4; ++kc) {
      f32x4 s2[2];
#pragma unroll
      for (int u = 0; u < 2; ++u) {
        const int kt = 2 * kc + u;
        s2[u] = (f32x4){0.f, 0.f, 0.f, 0.f};
        if (kt <= wave) {
#pragma unroll
          for (int ks = 0; ks < 2; ++ks) {
            bf16x8 kf = *(const bf16x8*)(lds + RET_KS + (kt * 16 + idx) * LDS_ROW + ks * 64 + quad * 16);
            s2[u] = mfma16(kf, q[ks], s2[u]);
          }
#pragma unroll
          for (int j = 0; j < 4; ++j) { const int key = kt * 16 + quad * 4 + j; s2[u][j] = (key <= i) ? s2[u][j] * fexp2((float)(i - key) * lg) : 0.f; }
        }
      }
      pb[kc] = as_bf8((u32x4){pk2(s2[0][0], s2[0][1]), pk2(s2[0][2], s2[0][3]), pk2(s2[1][0], s2[1][1]), pk2(s2[1][2], s2[1][3])});
    }
    f32x4 o[4], oi[4];
#pragma unroll
    for (int dvt = 0; dvt < 4; ++dvt) {
      o[dvt] = (f32x4){0.f, 0.f, 0.f, 0.f}; oi[dvt] = (f32x4){0.f, 0.f, 0.f, 0.f};
#pragma unroll
      for (int kc = 0; kc < 4; ++kc) {
        if (2 * kc <= wave) {
          const unsigned char* p = lds + RET_VT + (dvt * 16 + idx) * RET_ROWT + kc * 64 + quad * 8;
          u32x2 lo = *(const u32x2*)p, hi = *(const u32x2*)(p + 32);
          o[dvt] = mfma16(as_bf8((u32x4){lo.x, lo.y, hi.x, hi.y}), pb[kc], o[dvt]);
        }
      }
#pragma unroll
      for (int ks = 0; ks < 2; ++ks) {
        bf16x8 sf = *(const bf16x8*)(lds + RET_ST + (dvt * 16 + idx) * LDS_ROW + ks * 64 + quad * 16);
        oi[dvt] = mfma16(sf, q[ks], oi[dvt]);
      }
    }
    const float rd = fexp2((float)(i + 1) * lg);
#pragma unroll
    for (int dvt = 0; dvt < 4; ++dvt) o[dvt] += oi[dvt] * rd;
#pragma unroll
    for (int t = 0; t < 2; ++t) {
      f32x4 nw = (f32x4){0.f, 0.f, 0.f, 0.f};
#pragma unroll
      for (int kc = 0; kc < 4; ++kc) {
        bf16x8 vf = *(const bf16x8*)(lds + RET_VT + (et * 16 + idx) * RET_ROWT + kc * 64 + quad * 16);
        bf16x8 kf = *(const bf16x8*)(lds + RET_KWT + ((dt0 + t) * 16 + idx) * RET_ROWT + kc * 64 + quad * 16);
        nw = mfma16(vf, kf, nw);
      }
      st[t] = st[t] * cdecay + nw;
    }
    float sum = 0.f;
#pragma unroll
    for (int dvt = 0; dvt < 4; ++dvt) sum += o[dvt][0] + o[dvt][1] + o[dvt][2] + o[dvt][3];
    sum += shx<16>(sum); sum += shx32(sum, quad * 16 + idx);
    const float mu = sum * (1.f / 64.f);
    float var = 0.f;
#pragma unroll
    for (int dvt = 0; dvt < 4; ++dvt)
#pragma unroll
      for (int j = 0; j < 4; ++j) { float d = o[dvt][j] - mu; var += d * d; }
    var += shx<16>(var); var += shx32(var, quad * 16 + idx);
    const float rstd = rsqrtf(var * (1.f / 64.f) + 1e-6f);
#pragma unroll
    for (int dvt = 0; dvt < 4; ++dvt) {
      const int dv = dvt * 16 + quad * 4;
      const u32x2 gw = *(const u32x2*)(cx.proj + tokrow * PS + C_RG + h * 64 + dv);
      const float4 gg = *(const float4*)(gn + h * 64 + dv);
      float gt[4] = {__uint_as_float(gw.x << 16), __uint_as_float(gw.x & 0xffff0000u), __uint_as_float(gw.y << 16), __uint_as_float(gw.y & 0xffff0000u)};
      float gnv[4] = {gg.x, gg.y, gg.z, gg.w};
      f32x4 r;
#pragma unroll
      for (int j = 0; j < 4; ++j) r[j] = (o[dvt][j] - mu) * rstd * gnv[j] * (gt[j] * sigmoidf(gt[j]));
      store_bf4(cx.mixed + tokrow * DM + 704 + h * 64 + dv, r);
    }
  }
  __syncthreads();
}

DEVI int next_item(unsigned* ctr, int* slot, int wv) {
  __syncthreads();
  if (opaque_tid(wv) == 0) *slot = (int)atomicAdd(ctr, 1u);
  __syncthreads();
  return *slot;
}


constexpr size_t WS_SH = 501 * MiB;
constexpr int SPW = 2880;
DEVI void sk_gemm(const float* __restrict__ A, int lda, int K, const float* __restrict__ W, int N, const float* __restrict__ gain,
                  bool use_rs, float* __restrict__ out, int ldo, int mode, unsigned char* lds, int wv, int bid, int nblk) {
  const int tid = opaque_tid(wv), lane = tid & 63, wave = tid >> 6, c16 = lane & 15, kq = lane >> 4;
  float* As = (float*)lds; float* red = (float*)(lds + 65536); float* rsS = (float*)(lds + 98304);
  const int ngrp = (N + 15) >> 4;
  for (int grp = bid; grp < ngrp; grp += nblk) {
    const int n = grp * 16 + c16; const int nl = n < N ? n : N - 1;
    float acc[16];
#pragma unroll
    for (int b = 0; b < 16; ++b) acc[b] = 0.f;
#pragma unroll 1
    for (int k0 = 0; k0 < K; k0 += 1024) {
      const int kc = (K - k0) < 1024 ? (K - k0) : 1024;
      __syncthreads();
      {
        const int b = tid >> 5, j = tid & 31; float ss = 0.f;
#pragma unroll 8
        for (int k = j; k < kc; k += 32) { const float v = A[(size_t)b * lda + k0 + k]; ss += v * v; As[b * 1024 + k] = v * gain[k0 + k]; }
        if (use_rs) { ss += shx<16>(ss); ss += shx<8>(ss); ss += shx<4>(ss); ss += shx<2>(ss); ss += shx<1>(ss); if (j == 0) rsS[b] = rsqrtf(ss / (float)K + 1e-6f); }
      }
      __syncthreads();
      const int ks = kc >> 5;
      const int kb = (wave * 4 + kq) * ks;
      const float* Wp = W + (size_t)(k0 + kb) * N + nl;
      const float* Ap = As + kb;
#pragma unroll 2
      for (int k = 0; k < ks; k += 4) {
        const float w0 = Wp[(size_t)(k + 0) * N], w1 = Wp[(size_t)(k + 1) * N], w2 = Wp[(size_t)(k + 2) * N], w3 = Wp[(size_t)(k + 3) * N];
#pragma unroll
        for (int b = 0; b < 16; ++b) { const float4 a = *(const float4*)(Ap + b * 1024 + k); acc[b] += a.x * w0 + a.y * w1 + a.z * w2 + a.w * w3; }
      }
    }
#pragma unroll
    for (int b = 0; b < 16; ++b) { float v = acc[b]; v += shx<16>(v); v += shx32(v, lane); if (kq == 0) red[(wave * 16 + b) * 16 + c16] = v; }
    __syncthreads();
    if (tid < 256) {
      const int b = tid >> 4, c = tid & 15; float v = 0.f;
#pragma unroll
      for (int w = 0; w < 8; ++w) v += red[(w * 16 + b) * 16 + c];
      const int nn = grp * 16 + c;
      if (nn < N) {
        if (use_rs) v *= rsS[b];
        float* o = out + (size_t)b * ldo + nn;
        if (mode == 1) *o += v; else if (mode == 2) { v = fmaxf(v, 0.f); *o = v * v; } else *o = v;
      }
    }
    __syncthreads();
  }
}
DEVI float sig_acc(float x) { return 1.f / (1.f + expf(-x)); }
DEVI void sk_mixer(const Params& p, int l, const float* __restrict__ SP, float* __restrict__ SM, int b, unsigned char* lds, int wv) {
  const int tid = opaque_tid(wv);
  const float* P = SP + (size_t)b * SPW; float* M = SM + (size_t)b * 1024;
  float* tmp = (float*)lds;
  __syncthreads();
  if (tid < 384) { const int hh = tid >> 6, d = tid & 63, g = hh / 3; M[tid] = sig_acc(P[1152 + hh * 3 + 1]) * P[768 + g * 64 + d] + sig_acc(P[1152 + hh * 3 + 2]) * P[1024 + g * 64 + d]; }
  if (tid < 128) tmp[tid] = P[1426 + tid];
  __syncthreads();
  if (tid == 0) { float ss = 0.f; for (int c = 0; c < 128; ++c) ss += tmp[c] * tmp[c]; tmp[128] = rsqrtf(ss * (1.f / 128.f) + 1e-6f); }
  if (tid >= 320 && tid < 325) { const int h = tid - 320; float sd = 0.f; for (int d = 0; d < 64; ++d) sd += P[1586 + h * 64 + d] * P[1906 + h * 64 + d]; tmp[136 + h] = sd * 0.125f; }
  __syncthreads();
  if (tid < 320) {
    const int h = tid >> 6, d = tid & 63;
    const float* w = p.in[13] + (size_t)l * 128 * 640; const float* kn = p.in[12] + (size_t)l * 128;
    float a = 0.f; for (int k = 0; k < 128; ++k) a += tmp[k] * kn[k] * w[(size_t)k * 640 + h * 128 + 64 + d];
    M[384 + tid] = a * tmp[128];
    const float s00 = tmp[136 + h];
    float mu = 0.f; for (int e = 0; e < 64; ++e) mu += P[2226 + h * 64 + e]; mu *= s00 * (1.f / 64.f);
    float var = 0.f; for (int e = 0; e < 64; ++e) { const float dd = s00 * P[2226 + h * 64 + e] - mu; var += dd * dd; } var *= (1.f / 64.f);
    const float gt = P[2546 + h * 64 + d];
    M[704 + tid] = (s00 * P[2226 + h * 64 + d] - mu) * rsqrtf(var + 1e-6f) * p.in[14][(size_t)l * 320 + h * 64 + d] * (gt * sig_acc(gt));
  }
  __syncthreads();
}

namespace pg8 {
#define PG8_LAS __attribute__((address_space(3)))
typedef unsigned short bf16_t;
typedef short bf16x8 __attribute__((ext_vector_type(8)));
typedef float f32x4 __attribute__((ext_vector_type(4)));
typedef unsigned u32x4 __attribute__((ext_vector_type(4)));
constexpr int BM = 256, BK = 64, HALF = 128, HTB = HALF * BK * 2  , STAGE_BYTES = 8 * HTB, NXCD = 8, WGM = 8;

__host__ __device__ __forceinline__ int lds_byte(int r, int c) { const int st = (r >> 4) * 2 + (c >> 5), rr = r & 15, cc = c & 31, ob = rr * 64 + cc * 2; return st * 1024 + (ob ^ (((ob >> 9) & 1) << 5)); }
__host__ __device__ __forceinline__ void stage_rc(int b, int& R, int& C) { const int st = b / 1024, sb = b % 1024, swz = sb ^ (((sb >> 9) & 1) << 5); R = (st >> 1) * 16 + swz / 64; C = (st & 1) * 32 + (swz % 64) / 2; }
__host__ __device__ __forceinline__ int perm32(int rho) { const int n = rho >> 4, i = rho & 15; return 8 * (i >> 2) + 4 * n + (i & 3); }

struct Unit { int pm, pn; };
struct Gemm { const bf16_t* A; const bf16_t* Bt; int M, N, K; };

struct StaticOrder {
    int nM, nN, nwg, G, c;
    __host__ __device__ void init(int M, int N, int G_, int c_) { nM = M / BM; nN = N / BM; nwg = nM * nN; G = G_; c = c_; }
    __host__ __device__ bool next(int i, Unit& u) const {
        const long L = (long)i * G + c; if (L >= nwg) return false;
        int wgid = (int)L; { const int q = nwg / NXCD, r = nwg % NXCD, xcd = wgid % NXCD, off = wgid / NXCD; wgid = (xcd < r ? xcd * (q + 1) : r * (q + 1) + (xcd - r) * q) + off; }
        const int nig = WGM * nN, gid = wgid / nig, fm = gid * WGM, gsz = (nM - fm) < WGM ? (nM - fm) : WGM;
        u.pm = fm + ((wgid % nig) % gsz); u.pn = (wgid % nig) / gsz; return true;
    }
    __device__ __forceinline__ void a_ready(const Unit&) const {}
    __device__ __forceinline__ void done(const Unit&) const {}
};
template <class Epi, class Sched, bool ALIGN_EPI = false, bool SP2 = false>
__device__ __forceinline__ void gemm_phase(PG8_LAS unsigned char* lds, const Gemm g, const Sched& S, const Epi& E, int tid_in) {
    const int tid = tid_in, wid = __builtin_amdgcn_readfirstlane(tid >> 6), lane = tid & 63, wr = wid >> 2, wc = wid & 3, fr = lane & 15, fq = lane >> 4;
    const int K = g.K, nt = K / BK;
    unsigned voffA[2], voffB[2];
#pragma unroll
    for (int i = 0; i < 2; ++i) { int R, C; stage_rc(tid * 16 + i * 8192, R, C); const int Rb = Epi::PERM ? ((R & ~31) + perm32(R & 31)) : R;
        voffA[i] = (unsigned)(R * K + C) * 2u; voffB[i] = (unsigned)(Rb * K + C) * 2u; }
    const size_t kstep = (size_t)(BK * 2);
    const size_t hstep = (size_t)HALF * K * 2;
    const size_t tstep = 2 * hstep;
    const unsigned ldsw = (unsigned)wid * 1024u;
    const int aoff = lds_byte(wr * 64 + fr, fq * 8), boff = lds_byte(wc * 32 + fr, fq * 8);
#define PG8_SA(b, h) (((b) * 2 + (h)) * HTB)
#define PG8_SB(b, h) ((4 + (b) * 2 + (h)) * HTB)
#define PG8_STAGE(bufoff, gbase, voff) do { _Pragma("unroll") for (int _i = 0; _i < 2; ++_i) \
        __builtin_amdgcn_global_load_lds((const unsigned*)((const char*)(gbase) + (voff)[_i]), (PG8_LAS unsigned*)(lds + (bufoff) + ldsw + _i * 8192), 16, 0, 0); } while (0)
#define PG8_LDA(dst, b, h) do { _Pragma("unroll") for (int m = 0; m < 4; ++m) _Pragma("unroll") for (int k = 0; k < 2; ++k) dst[m][k] = *(const PG8_LAS bf16x8*)(lds + PG8_SA(b, h) + aoff + m * 2048 + k * 1024); } while (0)
#define PG8_LDB(dst, b, h) do { _Pragma("unroll") for (int n = 0; n < 2; ++n) _Pragma("unroll") for (int k = 0; k < 2; ++k) dst[n][k] = *(const PG8_LAS bf16x8*)(lds + PG8_SB(b, h) + boff + n * 2048 + k * 1024); } while (0)
#define PG8_MMA(ai, bj, At, Bt) do { __builtin_amdgcn_s_setprio(1); _Pragma("unroll") for (int m = 0; m < 4; ++m) _Pragma("unroll") for (int n = 0; n < 2; ++n) _Pragma("unroll") for (int k = 0; k < 2; ++k) \
        acc[ai][bj][m][n] = __builtin_amdgcn_mfma_f32_16x16x32_bf16(Bt[n][k], At[m][k], acc[ai][bj][m][n], 0, 0, 0); __builtin_amdgcn_s_setprio(0); } while (0)
#define PG8_WAIT_V(n) asm volatile("s_waitcnt vmcnt(" #n ")" ::: "memory")
#define PG8_WAIT_L(n) asm volatile("s_waitcnt lgkmcnt(" #n ")" ::: "memory")
#define PG8_BAR __builtin_amdgcn_s_barrier()
#define PG8_SCHED __builtin_amdgcn_sched_barrier(0)
    Unit cur, nxt; int ui = 0;
    if (!S.next(0, cur)) return;
    f32x4 acc[2][2][4][2];
#pragma unroll
    for (int a = 0; a < 2; ++a)
#pragma unroll
        for (int b = 0; b < 2; ++b)
#pragma unroll
            for (int m = 0; m < 4; ++m)
#pragma unroll
                for (int n = 0; n < 2; ++n) acc[a][b][m][n] = (f32x4){0.f, 0.f, 0.f, 0.f};
    bf16x8 At[4][2], B0[2][2], B1[2][2];
    const char* cA = (const char*)g.A + (size_t)cur.pm * tstep; const char* cB = (const char*)g.Bt + (size_t)cur.pn * tstep;
    S.a_ready(cur);
    if constexpr (SP2) {
        PG8_STAGE(PG8_SB(0, 0), cB, voffB); PG8_STAGE(PG8_SB(0, 1), cB + hstep, voffB); PG8_STAGE(PG8_SA(0, 0), cA, voffA); PG8_STAGE(PG8_SA(0, 1), cA + hstep, voffA);
        if (wr == 1) PG8_BAR;
        PG8_WAIT_V(2); PG8_BAR;
        PG8_STAGE(PG8_SB(1, 0), cB + kstep, voffB); PG8_STAGE(PG8_SA(1, 0), cA + kstep, voffA); PG8_STAGE(PG8_SB(1, 1), cB + hstep + kstep, voffB);
        PG8_WAIT_V(6); PG8_BAR;
    } else {
        PG8_STAGE(PG8_SB(0, 0), cB, voffB); PG8_STAGE(PG8_SA(0, 0), cA, voffA); PG8_STAGE(PG8_SB(0, 1), cB + hstep, voffB); PG8_STAGE(PG8_SA(0, 1), cA + hstep, voffA);
        if (wr == 1) PG8_BAR;
        PG8_WAIT_V(4); PG8_BAR;
        PG8_STAGE(PG8_SB(1, 0), cB + kstep, voffB); PG8_STAGE(PG8_SA(1, 0), cA + kstep, voffA); PG8_STAGE(PG8_SB(1, 1), cB + hstep + kstep, voffB);
        PG8_WAIT_V(6); PG8_BAR;
    }
    for (;;) {
        const bool has_next = S.next(ui + 1, nxt);
        const char* nA = has_next ? (const char*)g.A + (size_t)nxt.pm * tstep : cA; const char* nB = has_next ? (const char*)g.Bt + (size_t)nxt.pn * tstep : cB;
        for (int t = 0; t < nt; t += 2) {
            const bool last = (t == nt - 2);
            const char* a1 = cA + (size_t)(t + 1) * kstep;
            const char* a2 = last ? nA : cA + (size_t)(t + 2) * kstep; const char* b2 = last ? nB : cB + (size_t)(t + 2) * kstep;
            const char* a3 = a2 + kstep; const char* b3 = b2 + kstep;
            if (last && has_next) S.a_ready(nxt);
            if constexpr (SP2) {
            PG8_LDB(B0, 0, 0); PG8_LDB(B1, 0, 1); PG8_SCHED; PG8_LDA(At, 0, 0); PG8_STAGE(PG8_SA(1, 1), a1 + hstep, voffA);
            PG8_WAIT_V(8); PG8_WAIT_L(0); PG8_BAR; PG8_MMA(0, 0, At, B0); PG8_MMA(0, 1, At, B1); PG8_BAR; PG8_SCHED;
            PG8_LDA(At, 0, 1); PG8_STAGE(PG8_SB(0, 0), b2, voffB); PG8_STAGE(PG8_SB(0, 1), b2 + hstep, voffB); PG8_STAGE(PG8_SA(0, 0), a2, voffA);
            PG8_WAIT_V(8); PG8_WAIT_L(0); PG8_BAR; PG8_MMA(1, 0, At, B0); PG8_MMA(1, 1, At, B1); PG8_BAR; PG8_SCHED;
            PG8_LDB(B0, 1, 0); PG8_LDB(B1, 1, 1); PG8_SCHED; PG8_LDA(At, 1, 0); PG8_STAGE(PG8_SA(0, 1), a2 + hstep, voffA);
            PG8_WAIT_V(8); PG8_WAIT_L(0); PG8_BAR; PG8_MMA(0, 0, At, B0); PG8_MMA(0, 1, At, B1); PG8_BAR; PG8_SCHED;
            PG8_LDA(At, 1, 1); PG8_STAGE(PG8_SB(1, 0), b3, voffB); PG8_STAGE(PG8_SB(1, 1), b3 + hstep, voffB); PG8_STAGE(PG8_SA(1, 0), a3, voffA);
            PG8_WAIT_V(8); PG8_WAIT_L(0); PG8_BAR; PG8_MMA(1, 0, At, B0); PG8_MMA(1, 1, At, B1); PG8_BAR; PG8_SCHED;
            } else {
            PG8_LDB(B0, 0, 0); PG8_SCHED; PG8_LDA(At, 0, 0); PG8_STAGE(PG8_SA(1, 1), a1 + hstep, voffA);
            PG8_WAIT_L(8); PG8_BAR; PG8_WAIT_L(0); PG8_MMA(0, 0, At, B0); PG8_BAR; PG8_SCHED;
            PG8_LDB(B1, 0, 1); PG8_STAGE(PG8_SB(0, 0), b2, voffB);
            PG8_BAR; PG8_WAIT_L(0); PG8_MMA(0, 1, At, B1); PG8_BAR;
            PG8_LDA(At, 0, 1); PG8_STAGE(PG8_SA(0, 0), a2, voffA);
            PG8_BAR; PG8_WAIT_L(0); PG8_MMA(1, 0, At, B0); PG8_BAR; PG8_SCHED;
            PG8_STAGE(PG8_SB(0, 1), b2 + hstep, voffB);
            PG8_WAIT_V(6); PG8_BAR; PG8_MMA(1, 1, At, B1); PG8_BAR;
            PG8_LDB(B0, 1, 0); PG8_SCHED; PG8_LDA(At, 1, 0); PG8_STAGE(PG8_SA(0, 1), a2 + hstep, voffA);
            PG8_WAIT_L(8); PG8_BAR; PG8_WAIT_L(0); PG8_MMA(0, 0, At, B0); PG8_BAR; PG8_SCHED;
            PG8_LDB(B1, 1, 1); PG8_STAGE(PG8_SB(1, 0), b3, voffB);
            PG8_BAR; PG8_WAIT_L(0); PG8_MMA(0, 1, At, B1); PG8_BAR;
            PG8_LDA(At, 1, 1); PG8_STAGE(PG8_SA(1, 0), a3, voffA);
            PG8_BAR; PG8_WAIT_L(0); PG8_MMA(1, 0, At, B0); PG8_BAR; PG8_SCHED;
            PG8_STAGE(PG8_SB(1, 1), b3 + hstep, voffB);
            PG8_WAIT_V(6); PG8_BAR; PG8_MMA(1, 1, At, B1); PG8_BAR;
            }
        }
        if constexpr (ALIGN_EPI) { if (wr == 0) PG8_BAR; }
        if constexpr (!Epi::AFTER_DRAIN) { E(acc, cur, wr, wc, fr, fq); S.done(cur); }
        if (!has_next) break;
#pragma unroll
        for (int a = 0; a < 2; ++a)
#pragma unroll
            for (int b = 0; b < 2; ++b)
#pragma unroll
                for (int m = 0; m < 4; ++m)
#pragma unroll
                    for (int n = 0; n < 2; ++n) acc[a][b][m][n] = (f32x4){0.f, 0.f, 0.f, 0.f};
        cur = nxt; cA = nA; cB = nB; ++ui;
        if constexpr (ALIGN_EPI) { if (wr == 1) PG8_BAR; }
    }
    PG8_WAIT_V(0);
    if constexpr (!ALIGN_EPI) { if (wr == 0) PG8_BAR; }
    PG8_BAR;
    if constexpr (Epi::AFTER_DRAIN) { E.fused(acc, cur, wr, wc, fr, fq, lds, wid, lane); S.done(cur); }
#undef PG8_SA
#undef PG8_SB
#undef PG8_STAGE
#undef PG8_LDA
#undef PG8_LDB
#undef PG8_MMA
#undef PG8_WAIT_V
#undef PG8_WAIT_L
#undef PG8_BAR
#undef PG8_SCHED
}
}

template <class E> struct EpiAdapt {
  static constexpr bool PERM = false, AFTER_DRAIN = false;
  E e; const float* ssrow;
  DEVI void operator()(const f32x4 (&acc)[2][2][4][2], const pg8::Unit& u, int wr, int wc, int fr, int fq) const {
#pragma unroll
    for (int ai = 0; ai < 2; ++ai)
#pragma unroll
      for (int m = 0; m < 4; ++m) {
        const int row = u.pm * 256 + ai * 128 + wr * 64 + m * 16 + fr;
        float rs = 1.f;
        if (ssrow) {
          const float4* sp = (const float4*)(ssrow + (size_t)row * 16);
          const float4 a = sp[0], b = sp[1], c = sp[2], d = sp[3];
          const float ssum = (((a.x + a.y) + (a.z + a.w)) + ((b.x + b.y) + (b.z + b.w))) + (((c.x + c.y) + (c.z + c.w)) + ((d.x + d.y) + (d.z + d.w)));
          rs = rsqrtf(ssum * (1.f / 1024.f) + 1e-6f);
        }
#pragma unroll
        for (int bj = 0; bj < 2; ++bj)
#pragma unroll
          for (int n = 0; n < 2; ++n) e(row, u.pn * 256 + bj * 128 + wc * 32 + n * 16 + fq * 4, acc[ai][bj][m][n], rs);
      }
  }
};
struct EpiAdaptResid {
  static constexpr bool PERM = true, AFTER_DRAIN = false;
  float* xf; bf16_t* xb; float* ssout; const float* snap;
  DEVI void operator()(const f32x4 (&acc)[2][2][4][2], const pg8::Unit& u, int wr, int wc, int fr, int fq) const {
#pragma unroll
    for (int ai = 0; ai < 2; ++ai)
#pragma unroll
      for (int m = 0; m < 4; ++m) {
        const int row = u.pm * 256 + ai * 128 + wr * 64 + m * 16 + fr;
        const bool use_snap = snap && (row & 2047) == 0;
        float ss = 0.f;
#pragma unroll
        for (int bj = 0; bj < 2; ++bj) {
          const int col = u.pn * 256 + bj * 128 + wc * 32 + fq * 8;
          float* p = xf + (size_t)row * DM + col;
          f32x4 x0 = *(const f32x4*)p, x1 = *(const f32x4*)(p + 4);
          x0 += acc[ai][bj][m][0]; x1 += acc[ai][bj][m][1];
          if (use_snap) { const float* sp = snap + (size_t)(row >> 11) * 1024 + col; x0 = *(const f32x4*)sp; x1 = *(const f32x4*)(sp + 4); }
          *(f32x4*)p = x0; *(f32x4*)(p + 4) = x1;
          u32x4 w; w.x = pk2(x0[0], x0[1]); w.y = pk2(x0[2], x0[3]); w.z = pk2(x1[0], x1[1]); w.w = pk2(x1[2], x1[3]);
          *(u32x4*)(xb + (size_t)row * DM + col) = w;
          ss += (x0[0] * x0[0] + x0[1] * x0[1] + x0[2] * x0[2] + x0[3] * x0[3]) + (x1[0] * x1[0] + x1[1] * x1[1] + x1[2] * x1[2] + x1[3] * x1[3]);
        }
        ss += shx<16>(ss); ss += shx32(ss, fq * 16 + fr);
        if (fq == 0) ssout[(size_t)row * 16 + u.pn * 4 + wc] = ss;
      }
  }
};
struct EpiAdaptRelu2 {
  static constexpr bool PERM = true, AFTER_DRAIN = false;
  bf16_t* uo; const float* ssrow;
  DEVI void operator()(const f32x4 (&acc)[2][2][4][2], const pg8::Unit& u, int wr, int wc, int fr, int fq) const {
#pragma unroll
    for (int ai = 0; ai < 2; ++ai)
#pragma unroll
      for (int m = 0; m < 4; ++m) {
        const int row = u.pm * 256 + ai * 128 + wr * 64 + m * 16 + fr;
        const float4* sp = (const float4*)(ssrow + (size_t)row * 16);
        const float4 a = sp[0], b = sp[1], c = sp[2], d = sp[3];
        const float ssum = (((a.x + a.y) + (a.z + a.w)) + ((b.x + b.y) + (b.z + b.w))) + (((c.x + c.y) + (c.z + c.w)) + ((d.x + d.y) + (d.z + d.w)));
        const float rs = rsqrtf(ssum * (1.f / 1024.f) + 1e-6f);
#pragma unroll
        for (int bj = 0; bj < 2; ++bj) {
          const int col = u.pn * 256 + bj * 128 + wc * 32 + fq * 8;
          float h[8];
#pragma unroll
          for (int j = 0; j < 4; ++j) { const float h0 = fmaxf(acc[ai][bj][m][0][j] * rs, 0.f), h1 = fmaxf(acc[ai][bj][m][1][j] * rs, 0.f); h[j] = h0 * h0; h[4 + j] = h1 * h1; }
          u32x4 w; w.x = pk2(h[0], h[1]); w.y = pk2(h[2], h[3]); w.z = pk2(h[4], h[5]); w.w = pk2(h[6], h[7]);
          *(u32x4*)(uo + (size_t)row * DFF + col) = w;
        }
      }
  }
};


DEVI void gbar(unsigned* ctr, unsigned& gen, int wv) {
  asm volatile("s_waitcnt vmcnt(0) lgkmcnt(0)" ::: "memory");
  __syncthreads();
  ++gen;
  const int tb = opaque_tid(wv);
  if (tb < 64) {
    __builtin_amdgcn_fence(__ATOMIC_RELEASE, "agent");
    asm volatile("s_waitcnt vmcnt(0)" ::: "memory");
    if (tb == 0) {
      __hip_atomic_fetch_add(ctr, 1u, __ATOMIC_RELAXED, __HIP_MEMORY_SCOPE_AGENT);
      const unsigned target = gen * 256u;
      while (__hip_atomic_load(ctr, __ATOMIC_RELAXED, __HIP_MEMORY_SCOPE_AGENT) < target) __builtin_amdgcn_s_sleep(1);
    }
    __builtin_amdgcn_fence(__ATOMIC_ACQUIRE, "agent");
    asm volatile("s_waitcnt vmcnt(0)" ::: "memory");
  }
  __syncthreads();
}


struct EpiAdaptInProjPM {
  static constexpr bool PERM = true, AFTER_DRAIN = false;
  bf16_t* proj; bf16_t* vslcT; bf16_t* vwinT; bf16_t* retvT; const float* rope; const float* ssrow;
  DEVI f32x4 xform(int m, int n, f32x4 v, float rs) const {
    v *= rs;
    int ri = -1; float sc = 1.f;
    if (n < C_VCMP) { int d = n & 63; if (d < 16) ri = d >> 1; if (n < C_KCMP) sc = QSCALE_NSA; }
    else if (n < C_KSLC) {}
    else if (n < C_GATE) { int d = n & 63; if (d < 16) ri = d >> 1; }
    else if (n < C_KPE) {}
    else if (n < C_RQ) { ri = 8 + ((n - C_KPE) >> 1); }
    else if (n < C_RG) { int d = (n - C_RQ) & 63; ri = 24 + (d >> 1); if (n >= C_RK) sc = 0.125f; }
    if (ri >= 0) {
      const float4 cs = *(const float4*)(rope + ((size_t)m * 56 + ri) * 2);
      float a0 = v[0] * cs.x - v[1] * cs.y, a1 = v[1] * cs.x + v[0] * cs.y;
      float a2 = v[2] * cs.z - v[3] * cs.w, a3 = v[3] * cs.z + v[2] * cs.w;
      v = (f32x4){a0, a1, a2, a3};
    }
    return v * sc;
  }
  DEVI void operator()(const f32x4 (&acc)[2][2][4][2], const pg8::Unit& u, int wr, int wc, int fr, int fq) const {
#pragma unroll 1
    for (int ai = 0; ai < 2; ++ai)
#pragma unroll
      for (int m = 0; m < 4; ++m) {
        const int row = u.pm * 256 + ai * 128 + wr * 64 + m * 16 + fr;
        const float4* sp = (const float4*)(ssrow + (size_t)row * 16);
        const float4 a = sp[0], b = sp[1], c = sp[2], d = sp[3];
        const float ssum = (((a.x + a.y) + (a.z + a.w)) + ((b.x + b.y) + (b.z + b.w))) + (((c.x + c.y) + (c.z + c.w)) + ((d.x + d.y) + (d.z + d.w)));
        const float rs = rsqrtf(ssum * (1.f / 1024.f) + 1e-6f);
#pragma unroll
        for (int bj = 0; bj < 2; ++bj) {
          const int col = u.pn * 256 + bj * 128 + wc * 32 + fq * 8;
          const f32x4 a0 = ai ? acc[1][bj][m][0] : acc[0][bj][m][0], a1 = ai ? acc[1][bj][m][1] : acc[0][bj][m][1];
          if (u.pn < 9) {
            const f32x4 v0 = xform(row, col, a0, rs), v1 = xform(row, col + 4, a1, rs);
            u32x4 w; w.x = pk2(v0[0], v0[1]); w.y = pk2(v0[2], v0[3]); w.z = pk2(v1[0], v1[1]); w.w = pk2(v1[2], v1[3]);
            *(u32x4*)(proj + (size_t)row * PS + col) = w;
          } else if (col < C_END) {
            const int bb = row >> 11, sq = row & 2047;
            bf16_t* dst;
            if (col < C_VWIN) { const int e = col - C_VSLC; dst = vslcT + ((size_t)((bb * 2 + (e >> 6)) * 64 + (e & 63))) * S + sq; }
            else if (col < C_RV) { const int e = col - C_VWIN; dst = vwinT + ((size_t)((bb * 2 + (e >> 6)) * 64 + (e & 63))) * S + sq; }
            else { const int e = col - C_RV; dst = retvT + ((size_t)((bb * 5 + (e >> 6)) * 64 + (e & 63))) * S + sq; }
#pragma unroll
            for (int j = 0; j < 4; ++j) { dst[(size_t)j * S] = f2bf(a0[j] * rs); dst[(size_t)(j + 4) * S] = f2bf(a1[j] * rs); }
          }
        }
      }
  }
};

__global__ void __launch_bounds__(512) mega(Params p) {
  cg::grid_group grid = cg::this_grid();
  extern __shared__ __attribute__((aligned(16))) unsigned char lds[];
  constexpr int nblk = 256; const int bid = blockIdx.x;
  const int wv = __builtin_amdgcn_readfirstlane((int)(threadIdx.x >> 6));
  unsigned char* ws = p.ws;
  Ctx cx;
  cx.proj = (bf16_t*)(ws + WS_PROJ); cx.mixed = (bf16_t*)(ws + WS_MIXED); cx.qm = (bf16_t*)(ws + WS_QM);
  cx.vslcT = (bf16_t*)(ws + WS_VSLCT); cx.vwinT = (bf16_t*)(ws + WS_VWINT); cx.xb = (bf16_t*)(ws + WS_XB);
  cx.kn = (bf16_t*)(ws + WS_KN); cx.retvT = (bf16_t*)(ws + WS_RETVT); cx.mlavT = (bf16_t*)(ws + WS_MLAVT);
  cx.hid = (bf16_t*)(ws + WS_HID); cx.kc = (bf16_t*)(ws + WS_KC); cx.vcT = (bf16_t*)(ws + WS_VCT); cx.u = (bf16_t*)(ws + WS_U);
  cx.rope = (float*)(ws + WS_ROPE); cx.c1 = (float*)(ws + WS_C1); cx.ctr = (unsigned*)(ws + WS_CTR);
  cx.win = (bf16_t*)(ws + WS_WIN); cx.wout = (bf16_t*)(ws + WS_WOUT); cx.wup = (bf16_t*)(ws + WS_WUP); cx.wdown = (bf16_t*)(ws + WS_WDOWN);
  cx.w1 = (bf16_t*)(ws + WS_W1); cx.w2 = (bf16_t*)(ws + WS_W2); cx.wuq = (bf16_t*)(ws + WS_WUQ); cx.wukv = (bf16_t*)(ws + WS_WUKV);
  float* xf = p.out;
  int* slot = (int*)(lds + LDS_SLOT);

  {
    const int tid = opaque_tid(wv);
    if (bid == 0 && tid < 256) cx.ctr[tid] = 0u;
    float* lt = (float*)lds;
    for (int it = bid; it < 4 * 1630; it += nblk) {
      const int l = it / 1630; int r = it % 1630;
      const float* src; int ldsrc; bf16_t* dst; int K; const float* gain = nullptr; int kind; int kt, nt;
      if (r < 384) { kind = 0; src = p.in[3] + (size_t)l * 1024 * 2866; ldsrc = 2866; dst = cx.win + (size_t)l * NIN * 1024; K = 1024; gain = p.in[2] + l * 1024; kt = r / 24; nt = r % 24; }
      else if (r < 512) { r -= 384; kind = 1; src = p.in[15] + (size_t)l * 1024 * 1024; ldsrc = 1024; dst = cx.wout + (size_t)l * 1024 * 1024; K = 1024; kt = r / 8; nt = r % 8; }
      else if (r < 1024) { r -= 512; kind = 2; src = p.in[17] + (size_t)l * 1024 * 4096; ldsrc = 4096; dst = cx.wup + (size_t)l * 4096 * 1024; K = 1024; gain = p.in[16] + l * 1024; kt = r / 32; nt = r % 32; }
      else if (r < 1536) { r -= 1024; kind = 3; src = p.in[18] + (size_t)l * 4096 * 1024; ldsrc = 1024; dst = cx.wdown + (size_t)l * 1024 * 4096; K = 4096; kt = r / 8; nt = r % 8; }
      else if (r < 1568) { r -= 1536; kind = 4; src = p.in[5] + (size_t)l * 2048 * 128; ldsrc = 128; dst = cx.w1 + (size_t)(l * 2 + 0) * 128 * 2048; K = 2048; kt = r; nt = 0; }
      else if (r < 1600) { r -= 1568; kind = 5; src = p.in[8] + (size_t)l * 2048 * 128; ldsrc = 128; dst = cx.w1 + (size_t)(l * 2 + 1) * 128 * 2048; K = 2048; kt = r; nt = 0; }
      else if (r < 1602) { r -= 1600; kind = 6; src = p.in[6] + (size_t)l * 128 * 64; ldsrc = 64; dst = cx.w2 + (size_t)(l * 2 + 0) * 128 * 128; K = 128; kt = r; nt = 0; }
      else if (r < 1604) { r -= 1602; kind = 7; src = p.in[9] + (size_t)l * 128 * 64; ldsrc = 64; dst = cx.w2 + (size_t)(l * 2 + 1) * 128 * 128; K = 128; kt = r; nt = 0; }
      else if (r < 1620) { r -= 1604; kind = 8; src = p.in[11] + (size_t)l * 256 * 480; ldsrc = 480; dst = cx.wuq + (size_t)l * 512 * 256; K = 256; gain = p.in[10] + l * 256; kt = r / 4; nt = r % 4; }
      else { r -= 1620; kind = 9; src = p.in[13] + (size_t)l * 128 * 640; ldsrc = 640; dst = cx.wukv + (size_t)l * 640 * 128; K = 128; gain = p.in[12] + l * 128; kt = r / 5; nt = r % 5; }
      transpose_tile(src, ldsrc, dst, K, kt * 64, nt * 128, gain, kind, lt, wv);
    }
    {
      const int lane = tid & 63, wave = tid >> 6;
      float* ssB = (float*)(ws + WS_SS) + (size_t)T * 16;
      for (int row = bid * 8 + wave; row < T; row += nblk * 8) {
        const float* r = p.in[0] + (size_t)row * DM; float ss = 0.f;
#pragma unroll
        for (int j = 0; j < 4; ++j) {
          const float4 v = *(const float4*)(r + j * 256 + lane * 4);
          *(float4*)(xf + (size_t)row * DM + j * 256 + lane * 4) = v;
          u32x2 w; w.x = pk2(v.x, v.y); w.y = pk2(v.z, v.w);
          *(u32x2*)(cx.xb + (size_t)row * DM + j * 256 + lane * 4) = w;
          ss += v.x * v.x + v.y * v.y + v.z * v.z + v.w * v.w;
        }
        ss += shx32(ss, lane); ss += shx<16>(ss); ss += shx<8>(ss); ss += shx<4>(ss); ss += shx<2>(ss); ss += shx<1>(ss);
        if (lane < 16) ssB[(size_t)row * 16 + lane] = lane == 0 ? ss : 0.f;
      }
    }
    {
      const int* pos = (const int*)p.in[1];
      for (int e = bid * 512 + tid; e < T * 56; e += nblk * 512) {
        const int t = e / 56, f = e % 56;
        double ex;
        if (f < 8) ex = -(2.0 * f / 16.0) * 13.122363377404328;
        else if (f < 24) ex = -(2.0 * (f - 8) / 32.0) * 13.122363377404328;
        else ex = -(2.0 * (f - 24) / 64.0) * 9.210340371976184;
        const double inv = exp(ex);
        const double x = (double)pos[t] * inv;
        const double k = rint(x * 0.15915494309189535);
        const double r = x - k * 6.283185307179586;
        const double r2 = r * r;
        double term = 1.0, cs = 1.0, ts = r, sn = r;
#pragma unroll
        for (int n = 1; n <= 13; ++n) {
          term *= -r2 * (1.0 / (double)((2 * n - 1) * (2 * n))); cs += term;
          ts *= -r2 * (1.0 / (double)((2 * n) * (2 * n + 1))); sn += ts;
        }
        cx.rope[(size_t)e * 2] = (float)cs; cx.rope[(size_t)e * 2 + 1] = (float)sn;
      }
    }
    if (bid < 8) {
      const int l = bid >> 1, kv = bid & 1;
      const float* pos = p.in[kv ? 7 : 4] + (size_t)l * 2048;
      const float* w1 = p.in[kv ? 8 : 5] + (size_t)l * 2048 * 128;
      const int n = tid & 127, part = tid >> 7;
      float a = 0.f;
      for (int k = part * 512; k < part * 512 + 512; ++k) a += pos[k] * w1[(size_t)k * 128 + n];
      float* red = (float*)lds;
      __syncthreads();
      red[tid] = a;
      __syncthreads();
      if (tid < 128) cx.c1[(l * 2 + kv) * 128 + tid] = red[tid] + red[tid + 128] + red[tid + 256] + red[tid + 384];
      __syncthreads();
    }
  }
  grid.sync();
  float* SX = (float*)(ws + WS_SH); float* SPb = SX + 16 * 1024; float* SM = SPb + 16 * SPW; float* SU = SM + 16 * 1024; float* SNAP = SU + 16 * 4096;
  float* ONES = SNAP + 4 * 16 * 1024;
  {
    const int tid = opaque_tid(wv);
    if (bid < 16) { for (int k = tid; k < DM; k += 512) SX[bid * 1024 + k] = p.in[0][(size_t)bid * S * DM + k]; }
    if (bid == 16) { for (int k = tid; k < 4096; k += 512) ONES[k] = 1.f; }
  }
  int sph = 0;
  auto shadow_step = [&]() {
    int bido = bid; asm volatile("" : "+s"(bido));
    if (sph <= 20 && sph % 5 == 0 && sph > 0 && bido < 16) {
      const int tid = opaque_tid(wv);
      for (int k = tid; k < DM; k += 512) SNAP[(size_t)((sph / 5 - 1) * 16 + bido) * 1024 + k] = SX[bido * 1024 + k];
    }
    if (sph < 20) {
      const int l = sph / 5, st = sph % 5;
      if (st == 0) sk_gemm(SX, 1024, 1024, p.in[3] + (size_t)l * 1024 * 2866, 2866, p.in[2] + l * 1024, true, SPb, SPW, 0, lds, wv, bid, nblk);
      else if (st == 1) { if (bido >= 240) sk_mixer(p, l, SPb, SM, bido - 240, lds, wv); }
      else if (st == 2) sk_gemm(SM, 1024, 1024, p.in[15] + (size_t)l * 1024 * 1024, 1024, ONES, false, SX, 1024, 1, lds, wv, bid, nblk);
      else if (st == 3) sk_gemm(SX, 1024, 1024, p.in[17] + (size_t)l * 1024 * 4096, 4096, p.in[16] + l * 1024, true, SU, 4096, 2, lds, wv, bid, nblk);
      else sk_gemm(SU, 4096, 4096, p.in[18] + (size_t)l * 4096 * 1024, 1024, ONES, false, SX, 1024, 1, lds, wv, bid, nblk);
    }
    ++sph;
  };

  unsigned gen = 0; unsigned* barw = cx.ctr + 4096;
  gbar(barw, gen, wv);
#pragma unroll 1
  for (int l = 0; l < 4; ++l) {
    shadow_step();
    {
      float* ssB = (float*)(ws + WS_SS) + (size_t)T * 16;
      const int tid = opaque_tid(wv);
      EpiAdaptInProjPM ep{cx.proj, cx.vslcT, cx.vwinT, cx.retvT, cx.rope, ssB};
      pg8::Gemm g{cx.xb, cx.win + (size_t)l * NIN * 1024, T, NIN, 1024};
      pg8::StaticOrder so; so.init(T, NIN, nblk, bid);
      __syncthreads();
      pg8::gemm_phase<EpiAdaptInProjPM, pg8::StaticOrder, true, true>((PG8_LAS unsigned char*)lds, g, so, ep, tid);
      __syncthreads();
    }
    gbar(barw, gen, wv);
    shadow_step();
    {
      unsigned* ctr = cx.ctr + l * 2;
      int it = next_item(ctr, slot, wv);
      while (it < 32) {
        const int kv = it & 1, mt = it >> 1;
        ADCmp ad{cx.proj + (kv ? C_VCMP : C_KCMP), PS};
        EpiCmp1 ep{cx.hid + (size_t)kv * 4096 * 128, cx.c1 + (l * 2 + kv) * 128};
        gemm_tile<false>(ad, cx.w1 + (size_t)(l * 2 + kv) * 128 * 2048, 2048, mt * 256, 0, ep, lds, wv);
        it = next_item(ctr, slot, wv);
      }
      SCHED_BARRIER();
      while (it < 544) {
        const int r = it - 32;
        ADLin ad{cx.proj + C_CQ, PS, 64};
        EpiMlaQ ep{cx.qm, cx.rope};
        gemm_tile<true>(ad, cx.wuq + (size_t)l * 512 * 256, 256, (r >> 2) * 256, (r & 3) * 128, ep, lds, wv);
        it = next_item(ctr, slot, wv);
      }
      SCHED_BARRIER();
      while (it < 1184) {
        const int r = it - 544;
        ADLin ad{cx.proj + C_CKV, PS, 64};
        EpiMlaKV ep{cx.kn, cx.mlavT};
        gemm_tile<true>(ad, cx.wukv + (size_t)l * 640 * 128, 128, (r / 5) * 256, (r % 5) * 128, ep, lds, wv);
        it = next_item(ctr, slot, wv);
      }
    }
    gbar(barw, gen, wv);
    shadow_step();
    {
      unsigned* ctr = cx.ctr + l * 2 + 1;
      const float* gn = p.in[14] + (size_t)l * 320;
      unsigned* cflag = cx.ctr + 64 + l * 16;
      int it = next_item(ctr, slot, wv);
      while (it < 32) {
        const int kv = it & 1, mt = it >> 1;
        ADLin ad{cx.hid + (size_t)kv * 4096 * 128, 128, 64};
        EpiCmp2 ep{cx.kc, cx.vcT, kv};
        gemm_tile<false>(ad, cx.w2 + (size_t)(l * 2 + kv) * 128 * 128, 128, mt * 256, 0, ep, lds, wv);
        asm volatile("s_waitcnt vmcnt(0)" ::: "memory");
        __syncthreads();
        const int tb = opaque_tid(wv);
        if (tb < 64) {
          __builtin_amdgcn_fence(__ATOMIC_RELEASE, "agent");
          asm volatile("s_waitcnt vmcnt(0)" ::: "memory");
          if (tb == 0) __hip_atomic_fetch_add(cflag + mt, 1u, __ATOMIC_RELAXED, __HIP_MEMORY_SCOPE_AGENT);
        }
        it = next_item(ctr, slot, wv);
      }
      it -= 32;
      while (it < 80) { ret_item(cx, gn, xf, p.in[2] + (size_t)l * 1024, p.in[3] + (size_t)l * 1024 * 2866, it / 5, it % 5, lds, wv); it = next_item(ctr, slot, wv) - 32; }
#pragma unroll 1
      for (int grp = 0; grp < 8; ++grp) {
        const int base = 80 + grp * 144;
        while (it < base + 80) { const int r = it - base; mla_item(cx, r / 5, r % 5, 7 - grp, lds, wv); it = next_item(ctr, slot, wv) - 32; }
        SCHED_BARRIER();
        while (it < base + 144) { const int r = it - base - 80; const int e = r & 31; nsa_item(cx, cflag, e >> 1, e & 1, (r < 32 ? 15 : 14) - 2 * grp, lds, wv); it = next_item(ctr, slot, wv) - 32; }
      }
    }
    gbar(barw, gen, wv);
    shadow_step();
    {
      float* ssA = (float*)(ws + WS_SS);
      const int tid = opaque_tid(wv);
      EpiAdaptResid ep{xf, cx.xb, ssA, nullptr};
      pg8::Gemm g{cx.mixed, cx.wout + (size_t)l * 1024 * 1024, T, 1024, 1024};
      pg8::StaticOrder so; so.init(T, 1024, nblk, bid);
      __syncthreads();
      pg8::gemm_phase<EpiAdaptResid, pg8::StaticOrder, true, true>((PG8_LAS unsigned char*)lds, g, so, ep, tid);
      __syncthreads();
    }
    gbar(barw, gen, wv);
    shadow_step();
    {
      float* ssA = (float*)(ws + WS_SS);
      const int tid = opaque_tid(wv);
      EpiAdaptRelu2 ep{cx.u, ssA};
      pg8::Gemm g{cx.xb, cx.wup + (size_t)l * 4096 * 1024, T, 4096, 1024};
      pg8::StaticOrder so; so.init(T, 4096, nblk, bid);
      __syncthreads();
      pg8::gemm_phase<EpiAdaptRelu2, pg8::StaticOrder, true, true>((PG8_LAS unsigned char*)lds, g, so, ep, tid);
      __syncthreads();
    }
    gbar(barw, gen, wv);
    shadow_step();
    {
      float* ssB = (float*)(ws + WS_SS) + (size_t)T * 16;
      const int tid = opaque_tid(wv);
      EpiAdaptResid ep{xf, cx.xb, ssB, l == 0 ? SX : SNAP + (size_t)l * 16 * 1024};
      pg8::Gemm g{cx.u, cx.wdown + (size_t)l * 1024 * 4096, T, 1024, 4096};
      pg8::StaticOrder so; so.init(T, 1024, nblk, bid);
      __syncthreads();
      pg8::gemm_phase<EpiAdaptResid, pg8::StaticOrder, true, true>((PG8_LAS unsigned char*)lds, g, so, ep, tid);
      __syncthreads();
    }
    gbar(barw, gen, wv);
  }
  {
    const float* fg = p.in[19];
    const int tid = opaque_tid(wv), lane = tid & 63, wave = tid >> 6;
    for (int t = bid * 8 + wave; t < T; t += nblk * 8) {
      float* r = xf + (size_t)t * DM;
      const float* rin = ((t & 2047) == 0) ? (SX + (size_t)(t >> 11) * 1024) : r;
      float4 v[4]; float ss = 0.f;
#pragma unroll
      for (int j = 0; j < 4; ++j) { v[j] = *(const float4*)(rin + j * 256 + lane * 4); ss += v[j].x * v[j].x + v[j].y * v[j].y + v[j].z * v[j].z + v[j].w * v[j].w; }
      ss += shx32(ss, lane); ss += shx<16>(ss); ss += shx<8>(ss); ss += shx<4>(ss); ss += shx<2>(ss); ss += shx<1>(ss);
      const float sc = rsqrtf(ss * (1.f / 1024.f) + 1e-6f);
#pragma unroll
      for (int j = 0; j < 4; ++j) {
        const float4 g = *(const float4*)(fg + j * 256 + lane * 4);
        float4 w; w.x = v[j].x * sc * g.x; w.y = v[j].y * sc * g.y; w.z = v[j].z * sc * g.z; w.w = v[j].w * sc * g.w;
        *(float4*)(r + j * 256 + lane * 4) = w;
      }
    }
  }
}

extern "C" void kernel_launch(void* const* d_in, const int* in_sizes, int n_in, void* d_out, int out_size,
                              void* d_ws, size_t ws_size, hipStream_t stream) {
  static int grid_blocks = 0;
  if (!grid_blocks) {
    int dev = 0, cus = 0, per_cu = 0;
    (void)hipGetDevice(&dev);
    (void)hipDeviceGetAttribute(&cus, hipDeviceAttributeMultiprocessorCount, dev);
    (void)hipFuncSetAttribute((const void*)mega, hipFuncAttributeMaxDynamicSharedMemorySize, LDS_TOTAL);
    (void)hipOccupancyMaxActiveBlocksPerMultiprocessor(&per_cu, (const void*)mega, 512, LDS_TOTAL);
    if (per_cu < 1) { fprintf(stderr, "occupancy query returned %d\n", per_cu); per_cu = 1; }
    (void)hipGetLastError();
    grid_blocks = 256;
    if (cus < 256) fprintf(stderr, "device has %d CUs, kernel needs 256\n", cus);
  }
  (void)hipMemsetAsync((unsigned char*)d_ws + WS_CTR + 4096 * 4, 0, 256, stream);
  Params p{};
  for (int i = 0; i < 20; ++i) p.in[i] = (const float*)d_in[i];
  p.out = (float*)d_out; p.ws = (unsigned char*)d_ws;
  void* args[] = {&p};
  hipError_t e = hipLaunchCooperativeKernel((const void*)mega, dim3(grid_blocks), dim3(512), args, LDS_TOTAL, stream);
  if (e != hipSuccess) fprintf(stderr, "cooperative launch failed: %s (grid %d)\n", hipGetErrorString(e), grid_blocks);
}
```
